# Optimizing an MI355X kernel written in HIP

```python
import math
import jax, jax.numpy as jnp
from jax import lax
import numpy as np

D_MODEL = 1024
BATCH = 4
SEQ = 8192
DEPTH = 2

N_MIXERS = 2
D_FF = 2816
RMS_EPS = 1e-6
LN_EPS = 1e-5
DN_HEAD_DIM = 128
DN_HEADS = D_MODEL // DN_HEAD_DIM
DN_WIDTH = DN_HEADS * DN_HEAD_DIM
DN_CONV = 4
DN_CHUNK = 64
SG_WIDTH = 2 * D_MODEL
SG_GROUPS = 8
SG_CHUNK = 128
N_A = (DEPTH + 1) // 2
N_B = DEPTH // 2

kernel_name = 'hybrid_deltanet_spatialgate_macaron'


def rmsnorm(x, g, eps=RMS_EPS):
    xf = x.astype(jnp.float32)
    y = xf * lax.rsqrt(jnp.mean(xf * xf, axis=-1, keepdims=True) + eps)
    return (y * g.astype(jnp.float32)).astype(x.dtype)


def layernorm(x, g, b, eps=LN_EPS):
    xf = x.astype(jnp.float32)
    mu = jnp.mean(xf, axis=-1, keepdims=True)
    xc = xf - mu
    y = xc * lax.rsqrt(jnp.mean(xc * xc, axis=-1, keepdims=True) + eps)
    return (y * g.astype(jnp.float32) + b.astype(jnp.float32)).astype(x.dtype)


def l2norm(x, eps=1e-6):
    return x * lax.rsqrt(jnp.sum(x * x, axis=-1, keepdims=True) + eps)


def swiglu(h, w_gate, w_up, w_down):
    return (jax.nn.silu(h @ w_gate) * (h @ w_up)) @ w_down


def causal_short_conv(x, w):
    K = w.shape[0]
    S = x.shape[1]
    xp = jnp.pad(x, ((0, 0), (K - 1, 0), (0, 0)))
    return sum(xp[:, j:j + S, :] * w[j] for j in range(K))


def gated_delta_rule(q, k, v, g, beta):
    B, H, S, Dk = q.shape
    Dv = v.shape[-1]
    C = DN_CHUNK
    N = S // C
    q = q * (Dk ** -0.5)
    q = q.reshape(B, H, N, C, Dk)
    k = k.reshape(B, H, N, C, Dk)
    v = v.reshape(B, H, N, C, Dv)
    g = g.reshape(B, H, N, C)
    beta = beta.reshape(B, H, N, C)
    gc = jnp.cumsum(g, axis=-1)
    causal = jnp.tril(jnp.ones((C, C), dtype=bool))
    strict = jnp.tril(jnp.ones((C, C), dtype=bool), -1)
    diff = gc[..., :, None] - gc[..., None, :]
    decay = jnp.where(causal, jnp.exp(jnp.where(causal, diff, 0.0)), 0.0)
    k_beta = k * beta[..., None]
    v_beta = v * beta[..., None]
    L = jnp.where(strict, jnp.einsum('bhnid,bhnjd->bhnij', k_beta, k) * decay, 0.0)
    A = L + jnp.eye(C, dtype=jnp.float32)
    rhs = jnp.concatenate([v_beta, k_beta * jnp.exp(gc)[..., None]], axis=-1)
    sol = lax.linalg.triangular_solve(A, rhs, left_side=True, lower=True, unit_diagonal=True)
    u = sol[..., :Dv]
    w = sol[..., Dv:]
    attn = jnp.where(causal, jnp.einsum('bhnid,bhnjd->bhnij', q, k) * decay, 0.0)
    q_dec = q * jnp.exp(gc)[..., None]
    k_dec = k * jnp.exp(gc[..., -1:] - gc)[..., None]
    g_last = jnp.exp(gc[..., -1])

    def step(state, xs):
        u_i, w_i, attn_i, qd_i, kd_i, gl_i = xs
        v_new = u_i - jnp.einsum('bhck,bhkv->bhcv', w_i, state)
        o = jnp.einsum('bhck,bhkv->bhcv', qd_i, state) + jnp.einsum('bhij,bhjv->bhiv', attn_i, v_new)
        state = state * gl_i[..., None, None] + jnp.einsum('bhck,bhcv->bhkv', kd_i, v_new)
        return state, o

    xs = tuple(jnp.moveaxis(t, 2, 0) for t in (u, w, attn, q_dec, k_dec, g_last))
    s0 = jnp.zeros((B, H, Dk, Dv), jnp.float32)
    _, o = lax.scan(step, s0, xs)
    return jnp.moveaxis(o, 0, 2).reshape(B, H, S, Dv)


def gated_deltanet(h, w_in, conv_w, a_log, dt_bias, norm_g, w_out):
    B, S, _ = h.shape
    H, Dh, W = DN_HEADS, DN_HEAD_DIM, DN_WIDTH
    f32 = jnp.float32
    proj = h @ w_in
    qkv = proj[..., :3 * W]
    z = proj[..., 3 * W:4 * W]
    b_raw = proj[..., 4 * W:4 * W + H]
    a_raw = proj[..., 4 * W + H:]
    qkv = jax.nn.silu(causal_short_conv(qkv, conv_w))
    q, k, v = jnp.split(qkv, 3, axis=-1)
    to_heads = lambda t: t.reshape(B, S, H, Dh).transpose(0, 2, 1, 3).astype(f32)
    q = l2norm(to_heads(q))
    k = l2norm(to_heads(k))
    v = to_heads(v)
    beta = jax.nn.sigmoid(b_raw.astype(f32)).transpose(0, 2, 1)
    g = (-jnp.exp(a_log.astype(f32)) *
         jax.nn.softplus(a_raw.astype(f32) + dt_bias.astype(f32))).transpose(0, 2, 1)
    o = gated_delta_rule(q, k, v, g, beta).transpose(0, 2, 1, 3)
    o = rmsnorm(o, norm_g) * jax.nn.silu(z.reshape(B, S, H, Dh).astype(f32))
    return o.reshape(B, S, W).astype(h.dtype) @ w_out


def spatial_gating(h, w_in, b_in, ln_g, ln_b, w_s, b_s, w_out):
    B, S, _ = h.shape
    E, G, C = SG_WIDTH, SG_GROUPS, SG_CHUNK
    N = S // C
    zz = jax.nn.gelu(h @ w_in + b_in, approximate=False)
    u = zz[..., :E]
    v = layernorm(zz[..., E:], ln_g, ln_b)
    mask = jnp.tril(jnp.ones((C, C), dtype=bool))
    w_c = jnp.where(mask, w_s, 0.0)
    vg = v.reshape(B, N, C, G, E // G)
    mixed = jnp.einsum('gts,bnsgc->bntgc', w_c, vg) + b_s.T[None, None, :, :, None]
    return (u * mixed.reshape(B, S, E)) @ w_out


def setup_inputs(seed: int = 0) -> dict:
    key = jax.random.key(seed)
    ks = jax.random.split(key, 20)
    D, F, H, Dh, W = D_MODEL, D_FF, DN_HEADS, DN_HEAD_DIM, DN_WIDTH
    E, G, C = SG_WIDTH, SG_GROUPS, SG_CHUNK
    nrm = jax.random.normal
    x = nrm(ks[0], (BATCH, SEQ, D), jnp.float32)
    norm_g = 1.0 + 0.02 * nrm(ks[1], (DEPTH, 6, D), jnp.float32)
    ffn_w_gate = nrm(ks[2], (DEPTH, 2, D, F), jnp.float32) * D ** -0.5
    ffn_w_up = nrm(ks[3], (DEPTH, 2, D, F), jnp.float32) * D ** -0.5
    ffn_w_down = nrm(ks[4], (DEPTH, 2, F, D), jnp.float32) * F ** -0.5
    dn_w_in = nrm(ks[5], (N_A, D, 4 * W + 2 * H), jnp.float32) * D ** -0.5
    dn_conv_w = nrm(ks[6], (N_A, DN_CONV, 3 * W), jnp.float32) * DN_CONV ** -0.5
    dn_a_log = jnp.log(jax.random.uniform(ks[7], (N_A, H), jnp.float32, minval=1.0, maxval=16.0))
    dt = jnp.exp(jax.random.uniform(ks[8], (N_A, H), jnp.float32,
                                    minval=math.log(1e-3), maxval=math.log(1e-1)))
    dn_dt_bias = dt + jnp.log(-jnp.expm1(-dt))
    dn_norm_g = 1.0 + 0.02 * nrm(ks[9], (N_A, Dh), jnp.float32)
    dn_w_out = nrm(ks[10], (N_A, W, D), jnp.float32) * W ** -0.5
    sg_w_in = nrm(ks[11], (N_B, D, 2 * E), jnp.float32) * D ** -0.5
    sg_b_in = 0.02 * nrm(ks[12], (N_B, 2 * E), jnp.float32)
    sg_ln_g = 1.0 + 0.02 * nrm(ks[13], (N_B, E), jnp.float32)
    sg_ln_b = 0.02 * nrm(ks[14], (N_B, E), jnp.float32)
    sg_w_s = nrm(ks[15], (N_B, G, C, C), jnp.float32) * C ** -0.5
    sg_b_s = 1.0 + 0.02 * nrm(ks[16], (N_B, G, C), jnp.float32)
    sg_w_out = nrm(ks[17], (N_B, E, D), jnp.float32) * E ** -0.5
    return {'x': x, 'norm_g': norm_g, 'ffn_w_gate': ffn_w_gate, 'ffn_w_up': ffn_w_up,
            'ffn_w_down': ffn_w_down, 'dn_w_in': dn_w_in, 'dn_conv_w': dn_conv_w,
            'dn_a_log': dn_a_log, 'dn_dt_bias': dn_dt_bias, 'dn_norm_g': dn_norm_g,
            'dn_w_out': dn_w_out, 'sg_w_in': sg_w_in, 'sg_b_in': sg_b_in, 'sg_ln_g': sg_ln_g,
            'sg_ln_b': sg_ln_b, 'sg_w_s': sg_w_s, 'sg_b_s': sg_b_s, 'sg_w_out': sg_w_out}


def reference(x, norm_g, ffn_w_gate, ffn_w_up, ffn_w_down, dn_w_in, dn_conv_w, dn_a_log,
              dn_dt_bias, dn_norm_g, dn_w_out, sg_w_in, sg_b_in, sg_ln_g, sg_ln_b, sg_w_s,
              sg_b_s, sg_w_out):
    for i in range(DEPTH):
        ng = norm_g[i]
        h = rmsnorm(x, ng[0])
        x = x + 0.5 * rmsnorm(swiglu(h, ffn_w_gate[i, 0], ffn_w_up[i, 0], ffn_w_down[i, 0]), ng[1])
        h = rmsnorm(x, ng[2])
        j = i // N_MIXERS
        if i % N_MIXERS == 0:
            m = gated_deltanet(h, dn_w_in[j], dn_conv_w[j], dn_a_log[j], dn_dt_bias[j],
                               dn_norm_g[j], dn_w_out[j])
        else:
            m = spatial_gating(h, sg_w_in[j], sg_b_in[j], sg_ln_g[j], sg_ln_b[j], sg_w_s[j],
                               sg_b_s[j], sg_w_out[j])
        x = x + rmsnorm(m, ng[3])
        h = rmsnorm(x, ng[4])
        x = x + 0.5 * rmsnorm(swiglu(h, ffn_w_gate[i, 1], ffn_w_up[i, 1], ffn_w_down[i, 1]), ng[5])
    return x
```

```cpp
#include <hip/hip_runtime.h>
#include <hip/hip_cooperative_groups.h>
#include <cstdio>
namespace cg = cooperative_groups;

#ifndef MK_ONE_LAUNCH
#define MK_ONE_LAUNCH 1
#endif

#define LAS __attribute__((address_space(3)))
typedef unsigned short bf16_t;
typedef short bf16x8 __attribute__((ext_vector_type(8)));
typedef float f32x4 __attribute__((ext_vector_type(4)));
typedef float f32x2 __attribute__((ext_vector_type(2)));
typedef unsigned u32x4 __attribute__((ext_vector_type(4)));
typedef unsigned u32x2 __attribute__((ext_vector_type(2)));

constexpr int T = 32768, DM = 1024, FF = 2816, SEQ = 8192;
constexpr int NTHR = 512;
constexpr size_t MiB = 1048576;
constexpr size_t SZ_WGU = (size_t)5632 * 1024 * 2, SZ_WD = (size_t)1024 * 2816 * 2;
constexpr size_t OFF_WGU = 0;
constexpr size_t OFF_WD = OFF_WGU + 4 * SZ_WGU;
constexpr size_t OFF_WDNIN = OFF_WD + 4 * SZ_WD;
constexpr size_t OFF_WDNOUT = OFF_WDNIN + (size_t)4352 * 1024 * 2;
constexpr size_t OFF_WSGIN = OFF_WDNOUT + (size_t)1024 * 1024 * 2;
constexpr size_t OFF_WSGOUT = OFF_WSGIN + (size_t)4096 * 1024 * 2;
constexpr size_t OFF_WS = OFF_WSGOUT + (size_t)1024 * 2048 * 2;
constexpr size_t OFF_GL = OFF_WS + (size_t)8 * 128 * 128 * 2;
constexpr size_t OFF_STATS = OFF_GL + (size_t)4096 * 4;
constexpr size_t AR = 94 * MiB;
static_assert(OFF_STATS + (size_t)T * 8 <= AR, "weights region overflow");
constexpr size_t OFF_H = AR, OFF_Y = AR + 64 * MiB, OFF_ACT = AR + 192 * MiB;
constexpr size_t OFF_QKV = AR + 226 * MiB, OFF_P = AR, OFF_Z = AR + 64 * MiB, OFF_BA = AR + 128 * MiB, OFF_HALO = AR + 130 * MiB, OFF_N = AR + 139 * MiB;
constexpr size_t OFF_U = AR + 192 * MiB, OFF_V = AR + 64 * MiB;
constexpr size_t WS_END = AR + 418 * MiB;

struct Params {
    const float* x; const float* norm_g; const float* w_gate; const float* w_up; const float* w_down;
    const float* dn_w_in; const float* dn_conv_w; const float* dn_a_log; const float* dn_dt_bias; const float* dn_norm_g; const float* dn_w_out;
    const float* sg_w_in; const float* sg_b_in; const float* sg_ln_g; const float* sg_ln_b; const float* sg_w_s; const float* sg_b_s; const float* sg_w_out;
    float* out; unsigned char* ws;
};

typedef __bf16 bf16x2_t __attribute__((ext_vector_type(2)));
__device__ __forceinline__ unsigned cvt_pk_bf16(float lo, float hi) { f32x2 v = {lo, hi}; bf16x2_t r = __builtin_convertvector(v, bf16x2_t); return __builtin_bit_cast(unsigned, r); }
__device__ __forceinline__ float bf_lo(unsigned u) { return __uint_as_float(u << 16); }
__device__ __forceinline__ float bf_hi(unsigned u) { return __uint_as_float(u & 0xffff0000u); }
__device__ __forceinline__ float bf2f(bf16_t b) { return __uint_as_float(((unsigned)b) << 16); }
__device__ __forceinline__ float silu_f(float v) { return v * __builtin_amdgcn_rcpf(1.0f + __expf(-v)); }
__device__ __forceinline__ float gelu_f(float v) {
    const float av = fabsf(v), t = __builtin_amdgcn_rcpf(av * 0.2316418882f + 1.0f);
    float q = t * 0.5307027145f + (-0.7265760135f); q = q * t + 0.7107068705f; q = q * t + (-0.142248368f); q = q * t + 0.127414796f; q = q * t;
    const float e = __builtin_amdgcn_exp2f((v * v) * (-0.72134752044f));
    const float m = v * (q * e);
    return v < 0.f ? m : v - m;
}
__host__ __device__ __forceinline__ int perm32(int rho) { const int n = rho >> 4, i = rho & 15; return 8 * (i >> 2) + 4 * n + (i & 3); }
__device__ __forceinline__ int otid() { int t = threadIdx.x; asm volatile("" : "+v"(t)); return t; }
__device__ __forceinline__ int obid() { int t = (int)blockIdx.x; asm volatile("" : "+s"(t)); return t; }
__device__ __forceinline__ int ogdim() { int t = (int)gridDim.x; asm volatile("" : "+s"(t)); return t; }
#define MF(x, y, acc) __builtin_amdgcn_mfma_f32_16x16x32_bf16((x), (y), (acc), 0, 0, 0)

namespace pg8 {
constexpr int BM = 256, BK = 64, HALF = 128, HTB = HALF * BK * 2, STAGE_BYTES = 8 * HTB, NXCD = 8, WGM = 8;
__host__ __device__ __forceinline__ int lds_byte(int r, int c) { const int st = (r >> 4) * 2 + (c >> 5), rr = r & 15, cc = c & 31, ob = rr * 64 + cc * 2; return st * 1024 + (ob ^ (((ob >> 9) & 1) << 5)); }
__host__ __device__ __forceinline__ void stage_rc(int b, int& R, int& C) { const int st = b / 1024, sb = b % 1024, swz = sb ^ (((sb >> 9) & 1) << 5); R = (st >> 1) * 16 + swz / 64; C = (st & 1) * 32 + (swz % 64) / 2; }
struct Unit { int pm, pn; };
struct Gemm { const bf16_t* A; const bf16_t* Bt; int M, N, K, lda; };
struct StaticOrder {
    int nM, nN, nwg, G, c;
    __host__ __device__ void init(int M, int N, int G_, int c_) { nM = M / BM; nN = N / BM; nwg = nM * nN; G = G_; c = c_; }
    __host__ __device__ bool next(int i, Unit& u) const {
        const long L = (long)i * G + c; if (L >= nwg) return false;
        int wgid = (int)L; { const int q = nwg / NXCD, r = nwg % NXCD, xcd = wgid % NXCD, off = wgid / NXCD; wgid = (xcd < r ? xcd * (q + 1) : r * (q + 1) + (xcd - r) * q) + off; }
        const int nig = WGM * nN, gid = wgid / nig, fm = gid * WGM, gsz = (nM - fm) < WGM ? (nM - fm) : WGM;
        u.pm = fm + ((wgid % nig) % gsz); u.pn = (wgid % nig) / gsz; return true;
    }
};

template <class Epi>
__device__ __forceinline__ void gemm_phase(LAS unsigned char* lds, const Gemm g, const StaticOrder& S, const Epi& E) {
    const int tid = otid(), wid = __builtin_amdgcn_readfirstlane(tid >> 6), lane = tid & 63, wr = wid >> 2, wc = wid & 3, fr = lane & 15, fq = lane >> 4;
    const int K = g.K, nt = K / BK, lda = g.lda;
    unsigned voffA[2], voffB[2];
#pragma unroll
    for (int i = 0; i < 2; ++i) { int R, C; stage_rc(tid * 16 + i * 8192, R, C);
        voffA[i] = (unsigned)(R * lda + C) * 2u; voffB[i] = (unsigned)(R * K + C) * 2u; }
    const size_t kstep = (size_t)(BK * 2);
    const size_t hstepA = (size_t)HALF * lda * 2, hstepB = (size_t)HALF * K * 2;
    const size_t tstepA = 2 * hstepA, tstepB = 2 * hstepB;
    const unsigned ldsw = (unsigned)wid * 1024u;
    const int aoff = lds_byte(wr * 64 + fr, fq * 8), boff = lds_byte(wc * 32 + fr, fq * 8);
#define PG8_SA(b, h) (((b) * 2 + (h)) * HTB)
#define PG8_SB(b, h) ((4 + (b) * 2 + (h)) * HTB)
#define PG8_STAGE(bufoff, gbase, voff) do { _Pragma("unroll") for (int _i = 0; _i < 2; ++_i) \
        __builtin_amdgcn_global_load_lds((const unsigned*)((const char*)(gbase) + (voff)[_i]), (LAS unsigned*)(lds + (bufoff) + ldsw + _i * 8192), 16, 0, 0); } while (0)
#define PG8_LDA(dst, b, h) do { _Pragma("unroll") for (int m = 0; m < 4; ++m) _Pragma("unroll") for (int k = 0; k < 2; ++k) dst[m][k] = *(const LAS bf16x8*)(lds + PG8_SA(b, h) + aoff + m * 2048 + k * 1024); } while (0)
#define PG8_LDB(dst, b, h) do { _Pragma("unroll") for (int n = 0; n < 2; ++n) _Pragma("unroll") for (int k = 0; k < 2; ++k) dst[n][k] = *(const LAS bf16x8*)(lds + PG8_SB(b, h) + boff + n * 2048 + k * 1024); } while (0)
#define PG8_MMA(ai, bj, At, Bt) do { __builtin_amdgcn_s_setprio(1); _Pragma("unroll") for (int m = 0; m < 4; ++m) _Pragma("unroll") for (int n = 0; n < 2; ++n) _Pragma("unroll") for (int k = 0; k < 2; ++k) \
        acc[ai][bj][m][n] = __builtin_amdgcn_mfma_f32_16x16x32_bf16(Bt[n][k], At[m][k], acc[ai][bj][m][n], 0, 0, 0); __builtin_amdgcn_s_setprio(0); } while (0)
#define PG8_WAIT_V(n) asm volatile("s_waitcnt vmcnt(" #n ")" ::: "memory")
#define PG8_WAIT_L(n) asm volatile("s_waitcnt lgkmcnt(" #n ")" ::: "memory")
#define PG8_BAR __builtin_amdgcn_s_barrier()
#define PG8_SCHED __builtin_amdgcn_sched_barrier(0)
    Unit cur, nxt; int ui = 0;
    if (!S.next(0, cur)) return;
    f32x4 acc[2][2][4][2];
#pragma unroll
    for (int a = 0; a < 2; ++a)
#pragma unroll
        for (int b = 0; b < 2; ++b)
#pragma unroll
            for (int m = 0; m < 4; ++m)
#pragma unroll
                for (int n = 0; n < 2; ++n) acc[a][b][m][n] = (f32x4){0.f, 0.f, 0.f, 0.f};
    bf16x8 At[4][2], B0[2][2], B1[2][2];
    const char* cA = (const char*)g.A + (size_t)cur.pm * tstepA; const char* cB = (const char*)g.Bt + (size_t)cur.pn * tstepB;
    PG8_STAGE(PG8_SB(0, 0), cB, voffB); PG8_STAGE(PG8_SA(0, 0), cA, voffA); PG8_STAGE(PG8_SB(0, 1), cB + hstepB, voffB); PG8_STAGE(PG8_SA(0, 1), cA + hstepA, voffA);
    if (wr == 1) PG8_BAR;
    PG8_WAIT_V(4); PG8_BAR;
    PG8_STAGE(PG8_SB(1, 0), cB + kstep, voffB); PG8_STAGE(PG8_SA(1, 0), cA + kstep, voffA); PG8_STAGE(PG8_SB(1, 1), cB + hstepB + kstep, voffB);
    PG8_WAIT_V(6); PG8_BAR;
    for (;;) {
        const bool has_next = S.next(ui + 1, nxt);
        const char* nA = has_next ? (const char*)g.A + (size_t)nxt.pm * tstepA : cA; const char* nB = has_next ? (const char*)g.Bt + (size_t)nxt.pn * tstepB : cB;
        for (int t = 0; t < nt; t += 2) {
            const bool last = (t == nt - 2);
            const char* a1 = cA + (size_t)(t + 1) * kstep;
            const char* a2 = last ? nA : cA + (size_t)(t + 2) * kstep; const char* b2 = last ? nB : cB + (size_t)(t + 2) * kstep;
            const char* a3 = a2 + kstep; const char* b3 = b2 + kstep;
            PG8_LDB(B0, 0, 0); PG8_SCHED; PG8_LDA(At, 0, 0); PG8_STAGE(PG8_SA(1, 1), a1 + hstepA, voffA);
            PG8_WAIT_L(8); PG8_BAR; PG8_WAIT_L(0); PG8_MMA(0, 0, At, B0); PG8_BAR; PG8_SCHED;
            PG8_LDB(B1, 0, 1); PG8_STAGE(PG8_SB(0, 0), b2, voffB);
            PG8_BAR; PG8_WAIT_L(0); PG8_MMA(0, 1, At, B1); PG8_BAR;
            PG8_LDA(At, 0, 1); PG8_STAGE(PG8_SA(0, 0), a2, voffA);
            PG8_BAR; PG8_WAIT_L(0); PG8_MMA(1, 0, At, B0); PG8_BAR; PG8_SCHED;
            PG8_STAGE(PG8_SB(0, 1), b2 + hstepB, voffB);
            PG8_WAIT_V(6); PG8_BAR; PG8_MMA(1, 1, At, B1); PG8_BAR;
            PG8_LDB(B0, 1, 0); PG8_SCHED; PG8_LDA(At, 1, 0); PG8_STAGE(PG8_SA(0, 1), a2 + hstepA, voffA);
            PG8_WAIT_L(8); PG8_BAR; PG8_WAIT_L(0); PG8_MMA(0, 0, At, B0); PG8_BAR; PG8_SCHED;
            PG8_LDB(B1, 1, 1); PG8_STAGE(PG8_SB(1, 0), b3, voffB);
            PG8_BAR; PG8_WAIT_L(0); PG8_MMA(0, 1, At, B1); PG8_BAR;
            PG8_LDA(At, 1, 1); PG8_STAGE(PG8_SA(1, 0), a3, voffA);
            PG8_BAR; PG8_WAIT_L(0); PG8_MMA(1, 0, At, B0); PG8_BAR; PG8_SCHED;
            PG8_STAGE(PG8_SB(1, 1), b3 + hstepB, voffB);
            PG8_WAIT_V(6); PG8_BAR; PG8_MMA(1, 1, At, B1); PG8_BAR;
        }
        E(acc, cur, wr, wc, fr, fq);
        if (!has_next) break;
#pragma unroll
        for (int a = 0; a < 2; ++a)
#pragma unroll
            for (int b = 0; b < 2; ++b)
#pragma unroll
                for (int m = 0; m < 4; ++m)
#pragma unroll
                    for (int n = 0; n < 2; ++n) acc[a][b][m][n] = (f32x4){0.f, 0.f, 0.f, 0.f};
        cur = nxt; cA = nA; cB = nB; ++ui;
    }
    PG8_WAIT_V(0);
    if (wr == 0) PG8_BAR;
    PG8_BAR;
#undef PG8_SA
#undef PG8_SB
#undef PG8_STAGE
#undef PG8_LDA
#undef PG8_LDB
#undef PG8_MMA
#undef PG8_WAIT_V
#undef PG8_WAIT_L
#undef PG8_BAR
#undef PG8_SCHED
}
}

struct EpiF32 {
    float* C; int ldc;
    __device__ __forceinline__ void operator()(const f32x4 (&acc)[2][2][4][2], const pg8::Unit& u, int wr, int wc, int fr, int fq) const {
        const int row0 = u.pm * 256 + wr * 64 + fr, col0 = u.pn * 256 + wc * 32 + 4 * fq;
#pragma unroll
        for (int ai = 0; ai < 2; ++ai)
#pragma unroll
            for (int m = 0; m < 4; ++m) { float* rowp = C + (size_t)(row0 + ai * 128 + m * 16) * ldc + col0;
#pragma unroll
                for (int bj = 0; bj < 2; ++bj)
#pragma unroll
                    for (int n = 0; n < 2; ++n) *(f32x4*)(rowp + bj * 128 + n * 16) = acc[ai][bj][m][n]; }
    }
};
struct EpiBf16Y {
    bf16_t* O;
    __device__ __forceinline__ void operator()(const f32x4 (&acc)[2][2][4][2], const pg8::Unit& u, int wr, int wc, int fr, int fq) const {
        const int row0 = u.pm * 256 + wr * 64 + fr, col0 = u.pn * 256 + wc * 32 + 8 * fq;
#pragma unroll
        for (int ai = 0; ai < 2; ++ai)
#pragma unroll
            for (int m = 0; m < 4; ++m) { bf16_t* rowp = O + (size_t)(row0 + ai * 128 + m * 16) * DM + col0;
#pragma unroll
                for (int bj = 0; bj < 2; ++bj) { const f32x4 v0 = acc[ai][bj][m][0], v1 = acc[ai][bj][m][1];
                    u32x4 w; w.x = cvt_pk_bf16(v0[0], v0[1]); w.y = cvt_pk_bf16(v0[2], v0[3]); w.z = cvt_pk_bf16(v1[0], v1[1]); w.w = cvt_pk_bf16(v1[2], v1[3]);
                    *(u32x4*)(rowp + bj * 128) = w; } }
    }
};
struct EpiSwiGLU {
    bf16_t* O;
    __device__ __forceinline__ void operator()(const f32x4 (&acc)[2][2][4][2], const pg8::Unit& u, int wr, int wc, int fr, int fq) const {
        const int row0 = u.pm * 256 + wr * 64 + fr, col0 = u.pn * 128 + wc * 32 + 8 * fq;
#pragma unroll
        for (int ai = 0; ai < 2; ++ai)
#pragma unroll
            for (int m = 0; m < 4; ++m) {
                float v[8];
#pragma unroll
                for (int n = 0; n < 2; ++n)
#pragma unroll
                    for (int j = 0; j < 4; ++j) v[n * 4 + j] = silu_f(acc[ai][0][m][n][j]) * acc[ai][1][m][n][j];
                u32x4 w; w.x = cvt_pk_bf16(v[0], v[1]); w.y = cvt_pk_bf16(v[2], v[3]); w.z = cvt_pk_bf16(v[4], v[5]); w.w = cvt_pk_bf16(v[6], v[7]);
                *(u32x4*)(O + (size_t)(row0 + ai * 128 + m * 16) * FF + col0) = w;
            }
    }
};
struct EpiDnIn {
    bf16_t* QKV; bf16_t* Z; float* BA; bf16_t* HALO;
    __device__ __forceinline__ void operator()(const f32x4 (&acc)[2][2][4][2], const pg8::Unit& u, int wr, int wc, int fr, int fq) const {
        const int row0 = u.pm * 256 + wr * 64 + fr;
#pragma unroll
        for (int ai = 0; ai < 2; ++ai)
#pragma unroll
            for (int m = 0; m < 4; ++m) {
                const int r = row0 + ai * 128 + m * 16;
#pragma unroll
                for (int bj = 0; bj < 2; ++bj) {
                    const int c0 = u.pn * 256 + bj * 128 + wc * 32 + 8 * fq;
                    const f32x4 v0 = acc[ai][bj][m][0], v1 = acc[ai][bj][m][1];
                    if (u.pn < 16) {
                        u32x4 w; w.x = cvt_pk_bf16(v0[0], v0[1]); w.y = cvt_pk_bf16(v0[2], v0[3]); w.z = cvt_pk_bf16(v1[0], v1[1]); w.w = cvt_pk_bf16(v1[2], v1[3]);
                        if (u.pn < 12) {
                            *(u32x4*)(QKV + (size_t)r * 3072 + c0) = w;
                            const int rl = r & 63;
                            if (rl >= 61) *(u32x4*)(HALO + ((size_t)(r >> 6) * 3 + (rl - 61)) * 3072 + c0) = w;
                        } else *(u32x4*)(Z + (size_t)r * 1024 + (c0 - 3072)) = w;
                    } else if (c0 < 4112) { *(f32x4*)(BA + (size_t)r * 16 + (c0 - 4096)) = v0; *(f32x4*)(BA + (size_t)r * 16 + (c0 - 4096) + 4) = v1; }
                }
            }
    }
};
struct EpiSgIn {
    bf16_t* U; bf16_t* V; const float* bias;
    __device__ __forceinline__ void operator()(const f32x4 (&acc)[2][2][4][2], const pg8::Unit& u, int wr, int wc, int fr, int fq) const {
        const int row0 = u.pm * 256 + wr * 64 + fr;
        bf16_t* base = u.pn < 8 ? U : V;
        const int cb = (u.pn < 8 ? u.pn : u.pn - 8) * 256;
        f32x4 bv[2][2];
#pragma unroll
        for (int bj = 0; bj < 2; ++bj)
#pragma unroll
            for (int n = 0; n < 2; ++n) bv[bj][n] = *(const f32x4*)(bias + u.pn * 256 + bj * 128 + wc * 32 + 8 * fq + 4 * n);
#pragma unroll
        for (int ai = 0; ai < 2; ++ai)
#pragma unroll
            for (int m = 0; m < 4; ++m) {
                const int r = row0 + ai * 128 + m * 16;
#pragma unroll
                for (int bj = 0; bj < 2; ++bj) {
                    const int c0 = cb + bj * 128 + wc * 32 + 8 * fq;
                    const f32x4 v0 = acc[ai][bj][m][0] + bv[bj][0], v1 = acc[ai][bj][m][1] + bv[bj][1];
                    u32x4 w; w.x = cvt_pk_bf16(gelu_f(v0[0]), gelu_f(v0[1])); w.y = cvt_pk_bf16(gelu_f(v0[2]), gelu_f(v0[3]));
                    w.z = cvt_pk_bf16(gelu_f(v1[0]), gelu_f(v1[1])); w.w = cvt_pk_bf16(gelu_f(v1[2]), gelu_f(v1[3]));
                    *(u32x4*)(base + (size_t)r * 2048 + c0) = w;
                }
            }
    }
};

template <class Epi>
__device__ __forceinline__ void run_gemm(LAS unsigned char* lds, const bf16_t* A, int lda, const bf16_t* Bt, int M, int N, int K, const Epi& E) {
    pg8::Gemm g; g.A = A; g.Bt = Bt; g.M = M; g.N = N; g.K = K; g.lda = lda;
    pg8::StaticOrder S; S.init(M, N, (int)ogdim(), obid());
    pg8::gemm_phase<Epi>(lds, g, S, E);
}

__device__ __forceinline__ void prep_weights(const Params& p, LAS unsigned char* lds) {
    LAS float* tile = (LAS float*)lds;
    const int tid = otid();
    const int total = 4 * 704 + 4 * 352 + 544 + 128 + 512 + 256;
    for (int unit = obid(); unit < total; unit += ogdim()) {
        int uu = unit, K, ldn, ncols; const float* src; bf16_t* dst; bool perm; int g2, kt;
        if (uu < 2816) { const int i = uu / 704; uu -= i * 704; K = 1024; g2 = uu >> 3; kt = uu & 7;
            const int g = 2 * g2, pn = g >> 3, bj = (g >> 2) & 1, wc = g & 3;
            src = (bj ? p.w_up : p.w_gate) + (size_t)i * 1024 * 2816 + (128 * pn + 32 * wc); ldn = 2816; ncols = 64; perm = true;
            dst = (bf16_t*)(p.ws + OFF_WGU + i * SZ_WGU);
        } else if ((uu -= 2816) < 1408) { const int i = uu / 352; uu -= i * 352; K = 2816; g2 = uu / 22; kt = uu % 22;
            src = p.w_down + (size_t)i * 2816 * 1024 + 64 * g2; ldn = 1024; ncols = 64; perm = true; dst = (bf16_t*)(p.ws + OFF_WD + i * SZ_WD);
        } else if ((uu -= 1408) < 544) { K = 1024; g2 = uu >> 3; kt = uu & 7; src = p.dn_w_in + 64 * g2; ldn = 4112; ncols = 4112 - 64 * g2; perm = true; dst = (bf16_t*)(p.ws + OFF_WDNIN);
        } else if ((uu -= 544) < 128) { K = 1024; g2 = uu >> 3; kt = uu & 7; src = p.dn_w_out + 64 * g2; ldn = 1024; ncols = 64; perm = true; dst = (bf16_t*)(p.ws + OFF_WDNOUT);
        } else if ((uu -= 128) < 512) { K = 1024; g2 = uu >> 3; kt = uu & 7; src = p.sg_w_in + 64 * g2; ldn = 4096; ncols = 64; perm = true; dst = (bf16_t*)(p.ws + OFF_WSGIN);
        } else { uu -= 512; K = 2048; g2 = uu >> 4; kt = uu & 15; src = p.sg_w_out + 64 * g2; ldn = 1024; ncols = 64; perm = true; dst = (bf16_t*)(p.ws + OFF_WSGOUT); }
        const int c4 = (tid & 15) * 4, k0 = tid >> 4, kb = kt * 128;
#pragma unroll
        for (int it = 0; it < 4; ++it) { const int k = k0 + 32 * it;
            f32x4 v = (f32x4){0.f, 0.f, 0.f, 0.f};
            if (c4 < ncols) v = *(const f32x4*)(src + (size_t)(kb + k) * ldn + c4);
            tile[k * 65 + c4] = v[0]; tile[k * 65 + c4 + 1] = v[1]; tile[k * 65 + c4 + 2] = v[2]; tile[k * 65 + c4 + 3] = v[3]; }
        __syncthreads();
#pragma unroll
        for (int it = 0; it < 2; ++it) {
            const int rho = (tid >> 4) + 32 * it, kseg = tid & 15, sc = (rho & 32) + (perm ? perm32(rho & 31) : (rho & 31));
            float v[8];
#pragma unroll
            for (int i = 0; i < 8; ++i) v[i] = tile[(kseg * 8 + i) * 65 + sc];
            u32x4 w; w.x = cvt_pk_bf16(v[0], v[1]); w.y = cvt_pk_bf16(v[2], v[3]); w.z = cvt_pk_bf16(v[4], v[5]); w.w = cvt_pk_bf16(v[6], v[7]);
            *(u32x4*)(dst + (size_t)(g2 * 64 + rho) * K + kb + kseg * 8) = w;
        }
        __syncthreads();
    }
    bf16_t* Ws = (bf16_t*)(p.ws + OFF_WS);
    for (int i = obid() * NTHR + tid; i < 8 * 128 * 128 / 2; i += ogdim() * NTHR) {
        const int e = i * 2, s = e & 127, t = (e >> 7) & 127;
        const f32x2 v = *(const f32x2*)(p.sg_w_s + e);
        ((unsigned*)Ws)[i] = cvt_pk_bf16(s <= t ? v.x : 0.f, (s + 1) <= t ? v.y : 0.f);
    }
}

__device__ __forceinline__ void phase_rowwise(const float* xin, float* xout, const bf16_t* y, const float* g_post, float coef, const float* g_pre, bf16_t* h) {
    const int tid_ = otid(), wid = tid_ >> 6, lane = tid_ & 63;
    for (int row0 = (obid() * 8 + wid) * 2; row0 < T; row0 += ogdim() * 16) {
        f32x4 xv[2][4]; u32x2 yv[2][4];
#pragma unroll
        for (int r = 0; r < 2; ++r)
#pragma unroll
            for (int i = 0; i < 4; ++i) { xv[r][i] = *(const f32x4*)(xin + (size_t)(row0 + r) * DM + i * 256 + lane * 4);
                if (y) yv[r][i] = *(const u32x2*)(y + (size_t)(row0 + r) * DM + i * 256 + lane * 4); }
        if (y) {
            float ss[2] = {0.f, 0.f}; f32x4 yf[2][4];
#pragma unroll
            for (int r = 0; r < 2; ++r)
#pragma unroll
                for (int i = 0; i < 4; ++i) { yf[r][i] = (f32x4){bf_lo(yv[r][i].x), bf_hi(yv[r][i].x), bf_lo(yv[r][i].y), bf_hi(yv[r][i].y)};
                    ss[r] += yf[r][i][0] * yf[r][i][0] + yf[r][i][1] * yf[r][i][1] + yf[r][i][2] * yf[r][i][2] + yf[r][i][3] * yf[r][i][3]; }
#pragma unroll
            for (int o = 32; o >= 1; o >>= 1) { ss[0] += __shfl_xor(ss[0], o); ss[1] += __shfl_xor(ss[1], o); }
#pragma unroll
            for (int r = 0; r < 2; ++r) { const float rs = rsqrtf(ss[r] * (1.0f / DM) + 1e-6f) * coef;
#pragma unroll
                for (int i = 0; i < 4; ++i) { const f32x4 gp = *(const f32x4*)(g_post + i * 256 + lane * 4); xv[r][i] += yf[r][i] * gp * rs; } }
        }
#pragma unroll
        for (int r = 0; r < 2; ++r)
#pragma unroll
            for (int i = 0; i < 4; ++i) *(f32x4*)(xout + (size_t)(row0 + r) * DM + i * 256 + lane * 4) = xv[r][i];
        if (g_pre) {
            float ss[2] = {0.f, 0.f};
#pragma unroll
            for (int r = 0; r < 2; ++r)
#pragma unroll
                for (int i = 0; i < 4; ++i) ss[r] += xv[r][i][0] * xv[r][i][0] + xv[r][i][1] * xv[r][i][1] + xv[r][i][2] * xv[r][i][2] + xv[r][i][3] * xv[r][i][3];
#pragma unroll
            for (int o = 32; o >= 1; o >>= 1) { ss[0] += __shfl_xor(ss[0], o); ss[1] += __shfl_xor(ss[1], o); }
#pragma unroll
            for (int r = 0; r < 2; ++r) { const float rs = rsqrtf(ss[r] * (1.0f / DM) + 1e-6f);
#pragma unroll
                for (int i = 0; i < 4; ++i) { const f32x4 gp = *(const f32x4*)(g_pre + i * 256 + lane * 4); const f32x4 hv = xv[r][i] * gp * rs;
                    u32x2 w; w.x = cvt_pk_bf16(hv[0], hv[1]); w.y = cvt_pk_bf16(hv[2], hv[3]);
                    *(u32x2*)(h + (size_t)(row0 + r) * DM + i * 256 + lane * 4) = w; } }
        }
    }
}

constexpr int QS_LD = 136, XT_LD = 72;
constexpr int L_LM = 0, L_SC = L_LM + 64 * 64 * 4, L_QS = L_SC + 5 * 64 * 4, L_KS = L_QS + 64 * QS_LD * 2, L_VS = L_KS + 64 * QS_LD * 2, L_AT = L_VS + 64 * QS_LD * 2,
              L_XT = L_AT + 64 * XT_LD * 2, L_KD = L_XT + 256 * XT_LD * 2, L_LB = L_KD + 128 * XT_LD * 2, L_SCR = L_LB + 64 * XT_LD * 2, L_D1END = L_SCR + 16 * 256 * 4;
static_assert(L_D1END <= 160 * 1024, "LDS");

__device__ __forceinline__ bf16x8 lds_frag(LAS unsigned char* base, int ld_elems, int r0, int k0, int fr, int fq) {
    return *(const LAS bf16x8*)(base + ((r0 + fr) * ld_elems + k0 + 8 * fq) * 2);
}

#define RELAUNDER() const int tid = otid(), wid = tid >> 6, lane = tid & 63, fr = lane & 15, fq = lane >> 4; (void)wid; (void)lane; (void)fr; (void)fq
__device__ __forceinline__ void phase_dn_local(const Params& p, int half, LAS unsigned char* lds, bool dry) {
    bf16_t* QKV = (bf16_t*)(p.ws + OFF_QKV); const bf16_t* HALO = (const bf16_t*)(p.ws + OFF_HALO); const float* BA = (const float*)(p.ws + OFF_BA);
    bf16_t* Pg = (bf16_t*)(p.ws + OFF_P); bf16_t* Ng = (bf16_t*)(p.ws + OFF_N); float* GL = (float*)(p.ws + OFF_GL);
    LAS float* sc_gc = (LAS float*)(lds + L_SC); LAS float* sc_beta = sc_gc + 64; LAS float* sc_egc = sc_gc + 128; LAS float* sc_ekd = sc_gc + 192;
    LAS float* Lm = (LAS float*)(lds + L_LM);
    for (int item = obid(); item < 2048; item += ogdim()) {
        const int n = item & 127, h = (item >> 7) & 7, bl = item >> 10, b = half * 2 + bl;
        const int t0 = b * SEQ + n * 64;
        float braw = 0.f, araw = 0.f;
        {
            const int t = otid();
            if (t < 64) { braw = BA[(size_t)(t0 + t) * 16 + h]; araw = BA[(size_t)(t0 + t) * 16 + 8 + h]; }
        }
        __syncthreads();
        {
            RELAUNDER();
            { LAS unsigned char* zp = lds + L_XT + (tid >> 1) * XT_LD * 2 + (tid & 1) * 64; const u32x4 z = (u32x4){0u, 0u, 0u, 0u};
              *(LAS u32x4*)zp = z; *(LAS u32x4*)(zp + 16) = z; *(LAS u32x4*)(zp + 32) = z; *(LAS u32x4*)(zp + 48) = z; }
            const int row = tid >> 3, seg = tid & 7;
#pragma unroll 1
            for (int part = 0; part < 3; ++part) {
                const int cb = part * 1024 + h * 128 + seg * 16;
                float a[16];
#pragma unroll
                for (int c = 0; c < 16; ++c) a[c] = 0.f;
#pragma unroll
                for (int j = 0; j < 4; ++j) {
                    const int rr = row - 3 + j;
                    const bf16_t* src = nullptr;
                    if (rr >= 0) src = QKV + (size_t)(t0 + rr) * 3072 + cb;
                    else if (n > 0) src = HALO + ((size_t)((t0 >> 6) - 1) * 3 + (rr + 3)) * 3072 + cb;
                    if (src) {
                        const u32x4 x0 = *(const u32x4*)src, x1 = *(const u32x4*)(src + 8);
                        const float* wj = p.dn_conv_w + j * 3072 + cb;
                        const f32x4 w0 = *(const f32x4*)wj, w1 = *(const f32x4*)(wj + 4), w2 = *(const f32x4*)(wj + 8), w3 = *(const f32x4*)(wj + 12);
                        a[0] += w0[0] * bf_lo(x0.x); a[1] += w0[1] * bf_hi(x0.x); a[2] += w0[2] * bf_lo(x0.y); a[3] += w0[3] * bf_hi(x0.y);
                        a[4] += w1[0] * bf_lo(x0.z); a[5] += w1[1] * bf_hi(x0.z); a[6] += w1[2] * bf_lo(x0.w); a[7] += w1[3] * bf_hi(x0.w);
                        a[8] += w2[0] * bf_lo(x1.x); a[9] += w2[1] * bf_hi(x1.x); a[10] += w2[2] * bf_lo(x1.y); a[11] += w2[3] * bf_hi(x1.y);
                        a[12] += w3[0] * bf_lo(x1.z); a[13] += w3[1] * bf_hi(x1.z); a[14] += w3[2] * bf_lo(x1.w); a[15] += w3[3] * bf_hi(x1.w);
                    }
                }
                float ss = 0.f;
#pragma unroll
                for (int c = 0; c < 16; ++c) { a[c] = silu_f(a[c]); ss += a[c] * a[c]; }
                float scl = 1.0f;
                if (part < 2) {
                    ss += __shfl_xor(ss, 1); ss += __shfl_xor(ss, 2); ss += __shfl_xor(ss, 4);
                    scl = rsqrtf(ss + 1e-6f) * (part == 0 ? 0.08838834764831845f : 1.0f);
                }
                u32x4 o0, o1;
                o0.x = cvt_pk_bf16(a[0] * scl, a[1] * scl); o0.y = cvt_pk_bf16(a[2] * scl, a[3] * scl); o0.z = cvt_pk_bf16(a[4] * scl, a[5] * scl); o0.w = cvt_pk_bf16(a[6] * scl, a[7] * scl);
                o1.x = cvt_pk_bf16(a[8] * scl, a[9] * scl); o1.y = cvt_pk_bf16(a[10] * scl, a[11] * scl); o1.z = cvt_pk_bf16(a[12] * scl, a[13] * scl); o1.w = cvt_pk_bf16(a[14] * scl, a[15] * scl);
                LAS unsigned char* dstp = lds + (part == 0 ? L_QS : part == 1 ? L_KS : L_VS) + (row * QS_LD + seg * 16) * 2;
                *(LAS u32x4*)dstp = o0; *(LAS u32x4*)(dstp + 16) = o1;
            }
        }
        if (otid() < 64) {
            const int lane = otid() & 63;
            const float beta = 1.0f / (1.0f + __expf(-braw));
            const float xx = araw + p.dn_dt_bias[h];
            const float sp = fmaxf(xx, 0.f) + log1pf(__expf(-fabsf(xx)));
            float g = -__expf(p.dn_a_log[h]) * sp;
#pragma unroll
            for (int o = 1; o < 64; o <<= 1) { const float t = __shfl_up(g, o); if (lane >= o) g += t; }
            const float glast = __shfl(g, 63);
            sc_gc[lane] = g; sc_beta[lane] = beta; sc_egc[lane] = __expf(g); sc_ekd[lane] = __expf(glast - g);
            if (lane == 0) GL[(b * 8 + h) * 128 + n] = __expf(glast);
        }
        __syncthreads();
        {
            RELAUNDER();
            const int kind = wid >> 2, fi = wid & 3;
            const int i = 16 * fi + fr; const float gci = sc_gc[i], bi = sc_beta[i];
            bf16x8 yf[4];
#pragma unroll
            for (int ks = 0; ks < 4; ++ks) yf[ks] = lds_frag(lds + (kind ? L_QS : L_KS), QS_LD, 16 * fi, 32 * ks, fr, fq);
            for (int fj = 0; fj < 4; ++fj) {
                f32x4 acc = (f32x4){0.f, 0.f, 0.f, 0.f};
                if (fj <= fi) {
#pragma unroll
                    for (int ks = 0; ks < 4; ++ks) acc = MF(lds_frag(lds + L_KS, QS_LD, 16 * fj, 32 * ks, fr, fq), yf[ks], acc);
                }
                const int j0 = 16 * fj + 4 * fq;
                float v[4];
#pragma unroll
                for (int r = 0; r < 4; ++r) { const int j = j0 + r; const bool keep = kind ? (j <= i) : (j < i);
                    v[r] = keep ? acc[r] * __expf(gci - sc_gc[j]) * (kind ? 1.0f : bi) : 0.f; }
                if (kind == 0) { *(LAS f32x4*)(Lm + i * 64 + j0) = (f32x4){v[0], v[1], v[2], v[3]};
                    u32x2 w; w.x = cvt_pk_bf16(v[0], v[1]); w.y = cvt_pk_bf16(v[2], v[3]); *(LAS u32x2*)(lds + L_LB + (i * XT_LD + j0) * 2) = w; }
                else { u32x2 w; w.x = cvt_pk_bf16(v[0], v[1]); w.y = cvt_pk_bf16(v[2], v[3]); *(LAS u32x2*)(lds + L_AT + (i * XT_LD + j0) * 2) = w; }
            }
            const int dk = tid & 127, cq = tid >> 7;
            float kv[16];
#pragma unroll
            for (int c = 0; c < 16; ++c) kv[c] = bf2f(*(const LAS bf16_t*)(lds + L_KS + ((16 * cq + c) * QS_LD + dk) * 2)) * sc_ekd[16 * cq + c];
            u32x4 o0, o1;
            o0.x = cvt_pk_bf16(kv[0], kv[1]); o0.y = cvt_pk_bf16(kv[2], kv[3]); o0.z = cvt_pk_bf16(kv[4], kv[5]); o0.w = cvt_pk_bf16(kv[6], kv[7]);
            o1.x = cvt_pk_bf16(kv[8], kv[9]); o1.y = cvt_pk_bf16(kv[10], kv[11]); o1.z = cvt_pk_bf16(kv[12], kv[13]); o1.w = cvt_pk_bf16(kv[14], kv[15]);
            LAS unsigned char* dstp = lds + L_KD + (dk * XT_LD + 16 * cq) * 2;
            *(LAS u32x4*)dstp = o0; *(LAS u32x4*)(dstp + 16) = o1;
        }
        __syncthreads();
#pragma unroll
        for (int I = 0; I < 4; ++I) {
            if (I > 0) {
                RELAUNDER();
                LAS float* scr = (LAS float*)(lds + L_SCR);
#pragma unroll
                for (int cfi = 0; cfi < 2; ++cfi) {
                    const int c0 = 32 * wid + 16 * cfi;
                    f32x4 acc = (f32x4){0.f, 0.f, 0.f, 0.f};
#pragma unroll
                    for (int ks = 0; ks < (I == 3 ? 2 : 1); ++ks)
                        acc = MF(lds_frag(lds + L_LB, XT_LD, 16 * I, 32 * ks, fr, fq), lds_frag(lds + L_XT, XT_LD, c0, 32 * ks, fr, fq), acc);
#pragma unroll
                    for (int r = 0; r < 4; ++r) scr[(4 * fq + r) * 256 + c0 + fr] = acc[r];
                }
                __syncthreads();
            }
            if (otid() < 256) {
                RELAUNDER();
                float x[16];
                const bool isw = tid >= 128; const int cc = tid & 127;
                LAS unsigned char* srcm = lds + (isw ? L_KS : L_VS);
                const LAS float* scr = (const LAS float*)(lds + L_SCR);
#pragma unroll
                for (int r = 0; r < 16; ++r) { const int i = 16 * I + r;
                    x[r] = bf2f(*(const LAS bf16_t*)(srcm + (i * QS_LD + cc) * 2)) * sc_beta[i] * (isw ? sc_egc[i] : 1.0f);
                    if (I > 0) x[r] -= scr[r * 256 + tid]; }
#pragma unroll
                for (int r = 1; r < 16; ++r) {
                    float sacc = x[r];
#pragma unroll
                    for (int k4 = 0; k4 < (r + 3) / 4; ++k4) {
                        const f32x4 l = *(const LAS f32x4*)(Lm + (16 * I + r) * 64 + 16 * I + 4 * k4);
                        sacc -= l[0] * x[4 * k4]; sacc -= l[1] * x[4 * k4 + 1]; sacc -= l[2] * x[4 * k4 + 2]; sacc -= l[3] * x[4 * k4 + 3];
                    }
                    x[r] = sacc;
                }
                LAS unsigned char* dstp = lds + L_XT + (tid * XT_LD + 16 * I) * 2;
                u32x4 w0, w1;
                w0.x = cvt_pk_bf16(x[0], x[1]); w0.y = cvt_pk_bf16(x[2], x[3]); w0.z = cvt_pk_bf16(x[4], x[5]); w0.w = cvt_pk_bf16(x[6], x[7]);
                w1.x = cvt_pk_bf16(x[8], x[9]); w1.y = cvt_pk_bf16(x[10], x[11]); w1.z = cvt_pk_bf16(x[12], x[13]); w1.w = cvt_pk_bf16(x[14], x[15]);
                *(LAS u32x4*)dstp = w0; *(LAS u32x4*)(dstp + 16) = w1;
            }
            __syncthreads();
        }
        {
            RELAUNDER();
            LAS unsigned char* uT = lds + L_XT; LAS unsigned char* wT = lds + L_XT + 128 * XT_LD * 2; LAS unsigned char* stg = lds + L_KS;
            const int frow = tid >> 4, fc16 = (tid & 15) * 8;
            {
                const int fi = wid & 3, cf0 = (wid >> 2) * 4, i = 16 * fi + fr;
                bf16x8 af[2];
#pragma unroll
                for (int ks = 0; ks < 2; ++ks) af[ks] = lds_frag(lds + L_AT, XT_LD, 16 * fi, 32 * ks, fr, fq);
                const float egi = sc_egc[i];
#pragma unroll
                for (int cf = 0; cf < 4; ++cf) {
                    const int c0 = 16 * (cf0 + cf);
                    f32x4 aw = (f32x4){0.f, 0.f, 0.f, 0.f}, au = aw;
#pragma unroll
                    for (int ks = 0; ks < 2; ++ks) { aw = MF(lds_frag(wT, XT_LD, c0, 32 * ks, fr, fq), af[ks], aw); au = MF(lds_frag(uT, XT_LD, c0, 32 * ks, fr, fq), af[ks], au); }
                    const u32x2 qv = *(const LAS u32x2*)(lds + L_QS + (i * QS_LD + c0 + 4 * fq) * 2);
                    u32x2 wr_, wo;
                    wr_.x = cvt_pk_bf16(bf_lo(qv.x) * egi - aw[0], bf_hi(qv.x) * egi - aw[1]); wr_.y = cvt_pk_bf16(bf_lo(qv.y) * egi - aw[2], bf_hi(qv.y) * egi - aw[3]);
                    wo.x = cvt_pk_bf16(au[0], au[1]); wo.y = cvt_pk_bf16(au[2], au[3]);
                    *(LAS u32x2*)(stg + (i * QS_LD + c0 + 4 * fq) * 2) = wr_;
                    *(LAS u32x2*)(stg + ((64 + i) * QS_LD + c0 + 4 * fq) * 2) = wo;
                }
            }
            __syncthreads();
            if (!dry) {
#pragma unroll
                for (int it = 0; it < 4; ++it) { const int row = frow + 32 * it;
                    const u32x4 v = *(const LAS u32x4*)(stg + (row * QS_LD + fc16) * 2);
                    *(u32x4*)(QKV + (size_t)(t0 + (row & 63)) * 3072 + (row >> 6) * 1024 + h * 128 + fc16) = v; }
            }
            __syncthreads();
            bf16_t* Pn = Pg + (size_t)((bl * 8 + h) * 128 + n) * 16384; bf16_t* Nn = Ng + (size_t)((bl * 8 + h) * 128 + n) * 16384;
            bf16x8 kf[2], uf[2];
#pragma unroll
            for (int ks = 0; ks < 2; ++ks) { kf[ks] = lds_frag(lds + L_KD, XT_LD, 16 * wid, 32 * ks, fr, fq); uf[ks] = lds_frag(uT, XT_LD, 16 * wid, 32 * ks, fr, fq); }
#pragma unroll
            for (int cf = 0; cf < 8; ++cf) {
                f32x4 ap = (f32x4){0.f, 0.f, 0.f, 0.f};
#pragma unroll
                for (int ks = 0; ks < 2; ++ks) ap = MF(lds_frag(wT, XT_LD, 16 * cf, 32 * ks, fr, fq), kf[ks], ap);
                u32x2 w1; w1.x = cvt_pk_bf16(ap[0], ap[1]); w1.y = cvt_pk_bf16(ap[2], ap[3]);
                *(LAS u32x2*)(stg + ((16 * wid + fr) * QS_LD + 16 * cf + 4 * fq) * 2) = w1;
            }
            __syncthreads();
            if (!dry) {
#pragma unroll
                for (int it = 0; it < 4; ++it) { const int row = frow + 32 * it;
                    *(u32x4*)(Pn + row * 128 + fc16) = *(const LAS u32x4*)(stg + (row * QS_LD + fc16) * 2); }
            }
            __syncthreads();
#pragma unroll
            for (int cf = 0; cf < 8; ++cf) {
                f32x4 an = (f32x4){0.f, 0.f, 0.f, 0.f};
#pragma unroll
                for (int ks = 0; ks < 2; ++ks) an = MF(lds_frag(lds + L_KD, XT_LD, 16 * cf, 32 * ks, fr, fq), uf[ks], an);
                u32x2 w2; w2.x = cvt_pk_bf16(an[0], an[1]); w2.y = cvt_pk_bf16(an[2], an[3]);
                *(LAS u32x2*)(stg + ((16 * wid + fr) * QS_LD + 16 * cf + 4 * fq) * 2) = w2;
            }
            __syncthreads();
            if (!dry) {
#pragma unroll
                for (int it = 0; it < 4; ++it) { const int row = frow + 32 * it;
                    *(u32x4*)(Nn + row * 128 + fc16) = *(const LAS u32x4*)(stg + (row * QS_LD + fc16) * 2); }
            }
        }
    }
}

__device__ __forceinline__ void phase_dn_scan(const Params& p, int half, LAS unsigned char* lds, bool dry) {
    const int tid = otid(), wid = tid >> 6, lane = tid & 63, fr = lane & 15, fq = lane >> 4;
    const bf16_t* Pg = (const bf16_t*)(p.ws + OFF_P); bf16_t* Ng = (bf16_t*)(p.ws + OFF_N); const float* GL = (const float*)(p.ws + OFF_GL);
    constexpr int ST_LD = 136;
    for (int blk = obid(); blk < 256; blk += ogdim()) {
        const int xcd = blk & 7, j = blk >> 3;
        if (j >= 16) continue;
        const int slice = j & 7, bh = xcd * 2 + (j >> 3), bl = bh >> 3, h = bh & 7, b = half * 2 + bl;
        const bf16_t* Pb = Pg + (size_t)((bl * 8 + h) * 128) * 16384 + (16 * wid + fr) * 128 + 8 * fq;
        bf16_t* Nb = Ng + (size_t)((bl * 8 + h) * 128) * 16384 + (slice * 16 + fr) * 128 + 16 * wid + 4 * fq;
        const float* glb = GL + (b * 8 + h) * 128;
        __syncthreads();
        float s[4] = {0.f, 0.f, 0.f, 0.f};
        *(LAS u32x2*)(lds + (fr * ST_LD + 16 * wid + 4 * fq) * 2) = (u32x2){0u, 0u};
        bf16x8 pf[4][4]; u32x2 nf[4];
        const float gla = glb[lane], glb2 = glb[64 + lane];
#define SC_LOAD(slot, nn) do { _Pragma("unroll") for (int ks = 0; ks < 4; ++ks) pf[slot][ks] = *(const bf16x8*)(Pb + (size_t)(nn) * 16384 + 32 * ks); \
        nf[slot] = *(const u32x2*)(Nb + (size_t)(nn) * 16384); } while (0)
        SC_LOAD(0, 0); SC_LOAD(1, 1); SC_LOAD(2, 2); SC_LOAD(3, 3);
        for (int n4 = 0; n4 < 128; n4 += 4) {
#pragma unroll
            for (int u = 0; u < 4; ++u) {
                const int n = n4 + u;
                asm volatile("s_waitcnt lgkmcnt(0)" ::: "memory"); __builtin_amdgcn_s_barrier(); asm volatile("" ::: "memory");
                LAS unsigned char* stc = lds + (n & 1) * (16 * ST_LD * 2); LAS unsigned char* stn = lds + ((n + 1) & 1) * (16 * ST_LD * 2);
                f32x4 acc0 = (f32x4){0.f, 0.f, 0.f, 0.f}, acc1 = acc0;
                acc0 = MF(pf[u][0], *(const LAS bf16x8*)(stc + (fr * ST_LD + 8 * fq) * 2), acc0);
                acc1 = MF(pf[u][1], *(const LAS bf16x8*)(stc + (fr * ST_LD + 32 + 8 * fq) * 2), acc1);
                acc0 = MF(pf[u][2], *(const LAS bf16x8*)(stc + (fr * ST_LD + 64 + 8 * fq) * 2), acc0);
                acc1 = MF(pf[u][3], *(const LAS bf16x8*)(stc + (fr * ST_LD + 96 + 8 * fq) * 2), acc1);
                const float gl = __uint_as_float(__builtin_amdgcn_readlane(__float_as_uint(n4 < 64 ? gla : glb2), n & 63));
                s[0] = gl * s[0] + bf_lo(nf[u].x) - (acc0[0] + acc1[0]); s[1] = gl * s[1] + bf_hi(nf[u].x) - (acc0[1] + acc1[1]);
                s[2] = gl * s[2] + bf_lo(nf[u].y) - (acc0[2] + acc1[2]); s[3] = gl * s[3] + bf_hi(nf[u].y) - (acc0[3] + acc1[3]);
                u32x2 w; w.x = cvt_pk_bf16(s[0], s[1]); w.y = cvt_pk_bf16(s[2], s[3]);
                *(LAS u32x2*)(stn + (fr * ST_LD + 16 * wid + 4 * fq) * 2) = w;
                if (!dry) *(u32x2*)(Nb + (size_t)n * 16384) = w;
                if (n + 4 < 128) SC_LOAD(u, n + 4);
            }
        }
#undef SC_LOAD
    }
}

__device__ __forceinline__ void phase_dn_out(const Params& p, int half, bool dry) {
    const int tid = otid(), wid = tid >> 6, lane = tid & 63, fr = lane & 15, fq = lane >> 4;
#ifdef DBG_PSRC
    bf16_t* QKV = (bf16_t*)(p.ws + OFF_QKV); const bf16_t* Ng = (const bf16_t*)(p.ws + OFF_P); const bf16_t* Z = (const bf16_t*)(p.ws + OFF_Z);
#else
    bf16_t* QKV = (bf16_t*)(p.ws + OFF_QKV); const bf16_t* Ng = (const bf16_t*)(p.ws + OFF_N); const bf16_t* Z = (const bf16_t*)(p.ws + OFF_Z);
#endif
    for (int it = obid(); it < 1024; it += ogdim()) {
        const int item = it * 2 + (wid >> 2), fi = wid & 3;
        const int n = item & 127, h = (item >> 7) & 7, bl = item >> 10, b = half * 2 + bl;
        const int t = b * SEQ + n * 64 + 16 * fi + fr;
        f32x4 acc[8];
#pragma unroll
        for (int f = 0; f < 8; ++f) acc[f] = (f32x4){0.f, 0.f, 0.f, 0.f};
        if (n > 0) {
            const bf16_t* St = Ng + (size_t)((bl * 8 + h) * 128 + n - 1) * 16384 + fr * 128 + 8 * fq;
            const bf16_t* Rp = QKV + (size_t)t * 3072 + h * 128 + 8 * fq;
#pragma unroll
            for (int ks = 0; ks < 4; ++ks) {
                const bf16x8 rf = *(const bf16x8*)(Rp + 32 * ks);
#pragma unroll
                #ifdef DBG_RONLY
                for (int f = 0; f < 8; ++f) acc[f] = MF(rf, rf, acc[f]);
#else
                for (int f = 0; f < 8; ++f) acc[f] = MF(*(const bf16x8*)(St + f * 16 * 128 + 32 * ks), rf, acc[f]);
#endif
            }
        }
        bf16_t* op = QKV + (size_t)t * 3072 + 1024 + h * 128 + 4 * fq;
        float ss = 0.f;
#pragma unroll
        for (int f = 0; f < 8; ++f) { const u32x2 o1 = *(const u32x2*)(op + 16 * f);
            acc[f][0] += bf_lo(o1.x); acc[f][1] += bf_hi(o1.x); acc[f][2] += bf_lo(o1.y); acc[f][3] += bf_hi(o1.y);
            ss += acc[f][0] * acc[f][0] + acc[f][1] * acc[f][1] + acc[f][2] * acc[f][2] + acc[f][3] * acc[f][3]; }
        ss += __shfl_xor(ss, 16); ss += __shfl_xor(ss, 32);
        const float rs = rsqrtf(ss * (1.0f / 128.0f) + 1e-6f);
        const bf16_t* zp = Z + (size_t)t * 1024 + h * 128 + 4 * fq;
#pragma unroll
        for (int f = 0; f < 8; ++f) {
            const u32x2 zv = *(const u32x2*)(zp + 16 * f); const f32x4 gn = *(const f32x4*)(p.dn_norm_g + 16 * f + 4 * fq);
            u32x2 w; w.x = cvt_pk_bf16(acc[f][0] * rs * gn[0] * silu_f(bf_lo(zv.x)), acc[f][1] * rs * gn[1] * silu_f(bf_hi(zv.x)));
            w.y = cvt_pk_bf16(acc[f][2] * rs * gn[2] * silu_f(bf_lo(zv.y)), acc[f][3] * rs * gn[3] * silu_f(bf_hi(zv.y)));
            if (!dry) *(u32x2*)(op + 16 * f) = w;
        }
    }
}

__device__ __forceinline__ void phase_sg_stats(const Params& p) {
    const int tid_ = otid(), wid = tid_ >> 6, lane = tid_ & 63;
    const bf16_t* V = (const bf16_t*)(p.ws + OFF_V); float* ST = (float*)(p.ws + OFF_STATS);
    for (int row = obid() * 8 + wid; row < T; row += ogdim() * 8) {
        float v[32]; float sum = 0.f;
#pragma unroll
        for (int i = 0; i < 4; ++i) { const u32x4 x = *(const u32x4*)(V + (size_t)row * 2048 + i * 512 + lane * 8);
            v[8 * i] = bf_lo(x.x); v[8 * i + 1] = bf_hi(x.x); v[8 * i + 2] = bf_lo(x.y); v[8 * i + 3] = bf_hi(x.y); v[8 * i + 4] = bf_lo(x.z); v[8 * i + 5] = bf_hi(x.z); v[8 * i + 6] = bf_lo(x.w); v[8 * i + 7] = bf_hi(x.w); }
#pragma unroll
        for (int i = 0; i < 32; ++i) sum += v[i];
#pragma unroll
        for (int o = 32; o >= 1; o >>= 1) sum += __shfl_xor(sum, o);
        const float mean = sum * (1.0f / 2048.0f); float q = 0.f;
#pragma unroll
        for (int i = 0; i < 32; ++i) { const float d = v[i] - mean; q += d * d; }
#pragma unroll
        for (int o = 32; o >= 1; o >>= 1) q += __shfl_xor(q, o);
        if (lane == 0) *(f32x2*)(ST + (size_t)row * 2) = (f32x2){mean, rsqrtf(q * (1.0f / 2048.0f) + 1e-5f)};
    }
}

constexpr int VT_LD = 136;
__device__ __forceinline__ void phase_sg_mix(const Params& p, LAS unsigned char* lds, bool dry) {
    const int tid = otid(), wid = tid >> 6, lane = tid & 63, fr = lane & 15, fq = lane >> 4;
    const bf16_t* V = (const bf16_t*)(p.ws + OFF_V); bf16_t* U = (bf16_t*)(p.ws + OFF_U); const float* ST = (const float*)(p.ws + OFF_STATS);
    const bf16_t* Ws = (const bf16_t*)(p.ws + OFF_WS);
    LAS float* lst = (LAS float*)(lds + 256 * VT_LD * 2);
    for (int item = obid(); item < 2048; item += ogdim()) {
        const int g = item & 7, cn = item >> 3, t0 = cn * 128;
        __syncthreads();
        if (tid < 256) lst[tid] = ST[(size_t)t0 * 2 + tid];
        __syncthreads();
        {
            const int c = tid & 255, sh = tid >> 8;
            const float lg = p.sg_ln_g[g * 256 + c], lb = p.sg_ln_b[g * 256 + c];
#pragma unroll 2
            for (int sg = 0; sg < 8; ++sg) {
                const int s0 = 64 * sh + 8 * sg; float v[8];
#pragma unroll
                for (int i = 0; i < 8; ++i) v[i] = (bf2f(V[(size_t)(t0 + s0 + i) * 2048 + g * 256 + c]) - lst[2 * (s0 + i)]) * lst[2 * (s0 + i) + 1] * lg + lb;
                u32x4 w; w.x = cvt_pk_bf16(v[0], v[1]); w.y = cvt_pk_bf16(v[2], v[3]); w.z = cvt_pk_bf16(v[4], v[5]); w.w = cvt_pk_bf16(v[6], v[7]);
                *(LAS u32x4*)(lds + (c * VT_LD + s0) * 2) = w;
            }
        }
        __syncthreads();
        f32x4 acc[8][2];
#pragma unroll
        for (int tf = 0; tf < 8; ++tf) { acc[tf][0] = (f32x4){0.f, 0.f, 0.f, 0.f}; acc[tf][1] = acc[tf][0]; }
        const bf16_t* Wg = Ws + (size_t)g * 16384 + fr * 128 + 8 * fq;
#pragma unroll
        for (int ks = 0; ks < 4; ++ks) {
            const bf16x8 v0 = lds_frag(lds, VT_LD, 32 * wid, 32 * ks, fr, fq), v1 = lds_frag(lds, VT_LD, 32 * wid + 16, 32 * ks, fr, fq);
#pragma unroll
            for (int tf = 0; tf < 8; ++tf) {
                if (32 * ks <= 16 * tf + 15) {
                    const bf16x8 wf = *(const bf16x8*)(Wg + tf * 16 * 128 + 32 * ks);
                    acc[tf][0] = MF(v0, wf, acc[tf][0]); acc[tf][1] = MF(v1, wf, acc[tf][1]);
                }
            }
        }
#pragma unroll
        for (int tf = 0; tf < 8; ++tf) {
            const int t = 16 * tf + fr; const float bs = p.sg_b_s[g * 128 + t];
#pragma unroll
            for (int cf = 0; cf < 2; ++cf) {
                bf16_t* up = U + (size_t)(t0 + t) * 2048 + g * 256 + 32 * wid + 16 * cf + 4 * fq;
                const u32x2 uv = *(const u32x2*)up;
                u32x2 w; w.x = cvt_pk_bf16(bf_lo(uv.x) * (acc[tf][cf][0] + bs), bf_hi(uv.x) * (acc[tf][cf][1] + bs));
                w.y = cvt_pk_bf16(bf_lo(uv.y) * (acc[tf][cf][2] + bs), bf_hi(uv.y) * (acc[tf][cf][3] + bs));
                if (!dry) *(u32x2*)up = w;
            }
        }
    }
}

constexpr int NPH = 27;
__device__ __forceinline__ bool probe_rep(int ph) {
#if PROBE_REP == 1
    return ph == 1 || ph == 2 || ph == 4 || ph == 11 || ph == 13 || ph == 14 || ph == 16 || ph == 17 || ph == 19 || ph == 22 || ph == 24 || ph == 25;
#elif PROBE_REP == 2
    return ph == 0 || ph == 3 || ph == 12 || ph == 15 || ph == 18 || ph == 23 || ph == 26 || ph == 20;
#elif PROBE_REP == 3
    return ph == 5 || ph == 8 || ph == 7 || ph == 10 || ph == 21;
#elif PROBE_REP == 4
    return ph == 6 || ph == 9;
#elif PROBE_REP == 5
    return ph == 1 || ph == 13 || ph == 16 || ph == 24;
#elif PROBE_REP == 7
    return ph == 5 || ph == 8;
#elif PROBE_REP == 8
    return ph == 21;
#elif PROBE_REP == 6
    return ph == 2 || ph == 14 || ph == 17 || ph == 25;
#else
    return false;
#endif
}
__device__ __forceinline__ void run_phase(const Params& p, int ph_, LAS unsigned char* lds) {
    const int ph = ph_ & 0xff; const float rcoef = (ph_ & 0x100) ? 0.0f : 1.0f;
    unsigned char* ws = p.ws;
    bf16_t* H = (bf16_t*)(ws + OFF_H); bf16_t* Y = (bf16_t*)(ws + OFF_Y); bf16_t* ACT = (bf16_t*)(ws + OFF_ACT);
    const float* ng = p.norm_g;
    int ffn = -1, sub = 0;
    if (ph >= 1 && ph <= 3) { ffn = 0; sub = ph - 1; }
    else if (ph >= 13 && ph <= 15) { ffn = 1; sub = ph - 13; }
    else if (ph >= 16 && ph <= 18) { ffn = 2; sub = ph - 16; }
    else if (ph >= 24 && ph <= 26) { ffn = 3; sub = ph - 24; }
    if (ffn >= 0) {
        if (sub == 0) { EpiSwiGLU e; e.O = ACT; run_gemm(lds, H, DM, (const bf16_t*)(ws + OFF_WGU + ffn * SZ_WGU), T, 2 * FF, DM, e); }
        else if (sub == 1) { EpiBf16Y e; e.O = Y; run_gemm(lds, ACT, FF, (const bf16_t*)(ws + OFF_WD + ffn * SZ_WD), T, DM, FF, e); }
        else {
            const int layer = ffn >> 1, second = ffn & 1;
            const float* gpost = ng + (layer * 6 + (second ? 5 : 1)) * DM;
            const float* gpre = second ? (layer == 0 ? ng + (1 * 6 + 0) * DM : nullptr) : ng + (layer * 6 + 2) * DM;
            phase_rowwise(p.out, p.out, Y, gpost, 0.5f * rcoef, gpre, H);
        }
        return;
    }
    switch (ph) {
    case 0: prep_weights(p, lds); phase_rowwise(p.x, p.out, nullptr, nullptr, 0.f, ng, H); break;
    case 4: { EpiDnIn e; e.QKV = (bf16_t*)(ws + OFF_QKV); e.Z = (bf16_t*)(ws + OFF_Z); e.BA = (float*)(ws + OFF_BA); e.HALO = (bf16_t*)(ws + OFF_HALO);
        run_gemm(lds, H, DM, (const bf16_t*)(ws + OFF_WDNIN), T, 4352, DM, e); } break;
    case 5: case 8: phase_dn_local(p, ph == 8 ? 1 : 0, lds, rcoef == 0.0f); break;
    case 6: case 9: phase_dn_scan(p, ph == 9 ? 1 : 0, lds, rcoef == 0.0f); break;
    case 7: case 10: phase_dn_out(p, ph == 10 ? 1 : 0, rcoef == 0.0f); break;
    case 11: { EpiBf16Y e; e.O = Y; run_gemm(lds, (const bf16_t*)(ws + OFF_QKV) + 1024, 3072, (const bf16_t*)(ws + OFF_WDNOUT), T, DM, DM, e); } break;
    case 12: phase_rowwise(p.out, p.out, Y, ng + 3 * DM, rcoef, ng + 4 * DM, H); break;
    case 19: { EpiSgIn e; e.U = (bf16_t*)(ws + OFF_U); e.V = (bf16_t*)(ws + OFF_V); e.bias = p.sg_b_in;
        run_gemm(lds, H, DM, (const bf16_t*)(ws + OFF_WSGIN), T, 4096, DM, e); } break;
    case 20: phase_sg_stats(p); break;
    case 21: phase_sg_mix(p, lds, rcoef == 0.0f); break;
    case 22: { EpiBf16Y e; e.O = Y; run_gemm(lds, (const bf16_t*)(ws + OFF_U), 2048, (const bf16_t*)(ws + OFF_WSGOUT), T, DM, 2048, e); } break;
    case 23: phase_rowwise(p.out, p.out, Y, ng + (6 + 3) * DM, rcoef, ng + (6 + 4) * DM, H); break;
    default: break;
    }
}

constexpr int LDS_BYTES = 157 * 1024;
static_assert(L_D1END <= LDS_BYTES && pg8::STAGE_BYTES <= LDS_BYTES && 256 * VT_LD * 2 + 1024 <= LDS_BYTES, "LDS budget");

__global__ __launch_bounds__(512, 2) void mega(Params p, int ph_lo, int ph_hi) {
    extern __shared__ __attribute__((aligned(16))) unsigned char shm[];
    LAS unsigned char* lds = (LAS unsigned char*)shm;
#ifdef TEST_PH
    run_phase(p, TEST_PH, lds);
#else
    for (int ph = ph_lo; ph < ph_hi; ++ph) {
        if (ph > ph_lo) cg::this_grid().sync();
#ifdef PROBE_REP
        if (probe_rep(ph)) {
            Params q0 = p;
            asm volatile("" : "+s"(q0.ws), "+s"(q0.out), "+s"(q0.norm_g), "+s"(q0.x));
            run_phase(q0, ph | 0x100, lds);
            cg::this_grid().sync();
        }
#endif
        Params q = p;
        asm volatile("" : "+s"(q.ws), "+s"(q.out), "+s"(q.norm_g), "+s"(q.x));
        asm volatile("" : "+s"(q.dn_conv_w), "+s"(q.dn_a_log), "+s"(q.dn_dt_bias), "+s"(q.dn_norm_g));
        asm volatile("" : "+s"(q.sg_b_in), "+s"(q.sg_ln_g), "+s"(q.sg_ln_b), "+s"(q.sg_b_s));
        run_phase(q, ph, lds);
    }
#endif
}

extern "C" void kernel_launch(void* const* d_in, const int* in_sizes, int n_in, void* d_out, int out_size, void* d_ws, size_t ws_size, hipStream_t stream) {
    static int grid = 0;
    if (grid == 0) {
        if (n_in != 18 || in_sizes[0] != T * DM || out_size != T * DM || ws_size < WS_END) { fprintf(stderr, "kernel_launch: unexpected shapes (n_in %d, ws %zu, need %zu)\n", n_in, ws_size, (size_t)WS_END); grid = -1; return; }
        if (hipFuncSetAttribute((const void*)mega, hipFuncAttributeMaxDynamicSharedMemorySize, LDS_BYTES) != hipSuccess) { fprintf(stderr, "kernel_launch: hipFuncSetAttribute failed\n"); grid = -1; return; }
        int dev = 0, cus = 0, per_cu = 0;
        hipGetDevice(&dev); hipDeviceGetAttribute(&cus, hipDeviceAttributeMultiprocessorCount, dev);
        hipOccupancyMaxActiveBlocksPerMultiprocessor(&per_cu, (const void*)mega, NTHR, LDS_BYTES);
        if (per_cu < 1) { fprintf(stderr, "kernel_launch: occupancy query says 0 blocks per CU\n"); grid = -1; return; }
        grid = cus;
    }
    if (grid < 0) return;
    Params p{};
    p.x = (const float*)d_in[0]; p.norm_g = (const float*)d_in[1]; p.w_gate = (const float*)d_in[2]; p.w_up = (const float*)d_in[3]; p.w_down = (const float*)d_in[4];
    p.dn_w_in = (const float*)d_in[5]; p.dn_conv_w = (const float*)d_in[6]; p.dn_a_log = (const float*)d_in[7]; p.dn_dt_bias = (const float*)d_in[8]; p.dn_norm_g = (const float*)d_in[9];
    p.dn_w_out = (const float*)d_in[10]; p.sg_w_in = (const float*)d_in[11]; p.sg_b_in = (const float*)d_in[12]; p.sg_ln_g = (const float*)d_in[13]; p.sg_ln_b = (const float*)d_in[14];
    p.sg_w_s = (const float*)d_in[15]; p.sg_b_s = (const float*)d_in[16]; p.sg_w_out = (const float*)d_in[17];
    p.out = (float*)d_out; p.ws = (unsigned char*)d_ws;
#if MK_ONE_LAUNCH
    int lo = 0, hi = NPH;
    void* args[] = {&p, &lo, &hi};
    hipError_t e = hipLaunchCooperativeKernel((const void*)mega, dim3(grid), dim3(NTHR), args, LDS_BYTES, stream);
    if (e != hipSuccess) fprintf(stderr, "cooperative launch failed: %s (grid %d)\n", hipGetErrorString(e), grid);
#else
    for (int ph = 0; ph < NPH; ++ph) {
#ifdef SKIP_DN
        if (ph >= 4 && ph <= 12) continue;
#endif
#ifdef DBG_NOSCAN
        if (ph == 6 || ph == 9) continue;
        if (ph >= 8 && ph <= 10) continue;
#endif
#ifdef SKIP_SG
        if (ph >= 19 && ph <= 23) continue;
#endif
        hipLaunchKernelGGL(mega, dim3(grid), dim3(NTHR), LDS_BYTES, stream, p, ph, ph + 1);
    }
#endif
}
```

```cpp
#include <hip/hip_runtime.h>
#include <hip/hip_cooperative_groups.h>
#include <cstdio>
namespace cg = cooperative_groups;

#ifndef MK_ONE_LAUNCH
#define MK_ONE_LAUNCH 1
#endif

#define LAS __attribute__((address_space(3)))
typedef unsigned short bf16_t;
typedef short bf16x8 __attribute__((ext_vector_type(8)));
typedef float f32x4 __attribute__((ext_vector_type(4)));
typedef float f32x2 __attribute__((ext_vector_type(2)));
typedef unsigned u32x4 __attribute__((ext_vector_type(4)));
typedef unsigned u32x2 __attribute__((ext_vector_type(2)));

constexpr int T = 32768, DM = 1024, FF = 2816, SEQ = 8192;
constexpr int NTHR = 512;
constexpr size_t MiB = 1048576;
constexpr size_t SZ_WGU = (size_t)5632 * 1024 * 2, SZ_WD = (size_t)1024 * 2816 * 2;
constexpr size_t OFF_WGU = 0;
constexpr size_t OFF_WD = OFF_WGU + 4 * SZ_WGU;
constexpr size_t OFF_WDNIN = OFF_WD + 4 * SZ_WD;
constexpr size_t OFF_WDNOUT = OFF_WDNIN + (size_t)4352 * 1024 * 2;
constexpr size_t OFF_WSGIN = OFF_WDNOUT + (size_t)1024 * 1024 * 2;
constexpr size_t OFF_WSGOUT = OFF_WSGIN + (size_t)4096 * 1024 * 2;
constexpr size_t OFF_WS = OFF_WSGOUT + (size_t)1024 * 2048 * 2;
constexpr size_t OFF_GL = OFF_WS + (size_t)8 * 128 * 128 * 2;
constexpr size_t OFF_STATS = OFF_GL + (size_t)4096 * 4;
constexpr size_t OFF_BAR = OFF_STATS + (size_t)T * 8;
constexpr int XCD_BAR_WORDS = 3456;
constexpr size_t AR = 94 * MiB;
static_assert(OFF_BAR + (size_t)XCD_BAR_WORDS * 4 <= AR, "weights region overflow");
constexpr size_t OFF_H = AR, OFF_Y = AR + 64 * MiB, OFF_ACT = AR + 192 * MiB;
constexpr size_t OFF_QKV = AR + 226 * MiB, OFF_P = AR, OFF_Z = AR + 64 * MiB, OFF_BA = AR + 128 * MiB, OFF_HALO = AR + 130 * MiB, OFF_N = AR + 139 * MiB;
constexpr size_t OFF_U = AR + 192 * MiB, OFF_V = AR + 64 * MiB;
constexpr size_t WS_END = AR + 418 * MiB;

struct Params {
    const float* x; const float* norm_g; const float* w_gate; const float* w_up; const float* w_down;
    const float* dn_w_in; const float* dn_conv_w; const float* dn_a_log; const float* dn_dt_bias; const float* dn_norm_g; const float* dn_w_out;
    const float* sg_w_in; const float* sg_b_in; const float* sg_ln_g; const float* sg_ln_b; const float* sg_w_s; const float* sg_b_s; const float* sg_w_out;
    float* out; unsigned char* ws;
};

typedef __bf16 bf16x2_t __attribute__((ext_vector_type(2)));
__device__ __forceinline__ unsigned cvt_pk_bf16(float lo, float hi) { f32x2 v = {lo, hi}; bf16x2_t r = __builtin_convertvector(v, bf16x2_t); return __builtin_bit_cast(unsigned, r); }
__device__ __forceinline__ float bf_lo(unsigned u) { return __uint_as_float(u << 16); }
__device__ __forceinline__ float bf_hi(unsigned u) { return __uint_as_float(u & 0xffff0000u); }
__device__ __forceinline__ float bf2f(bf16_t b) { return __uint_as_float(((unsigned)b) << 16); }
__device__ __forceinline__ float silu_f(float v) { return v * __builtin_amdgcn_rcpf(1.0f + __expf(-v)); }
__device__ __forceinline__ float gelu_f(float v) {
    const float av = fabsf(v), t = __builtin_amdgcn_rcpf(av * 0.2316418882f + 1.0f);
    float q = t * 0.5307027145f + (-0.7265760135f); q = q * t + 0.7107068705f; q = q * t + (-0.142248368f); q = q * t + 0.127414796f; q = q * t;
    const float e = __builtin_amdgcn_exp2f((v * v) * (-0.72134752044f));
    const float m = v * (q * e);
    return v < 0.f ? m : v - m;
}
__device__ __forceinline__ f32x2 gelu_pk(f32x2 v) {
    const f32x2 av = __builtin_elementwise_abs(v), d = av * 0.2316418882f + 1.0f;
    f32x2 t; t.x = __builtin_amdgcn_rcpf(d.x); t.y = __builtin_amdgcn_rcpf(d.y);
    f32x2 q = t * 0.5307027145f + (-0.7265760135f); q = q * t + 0.7107068705f; q = q * t + (-0.142248368f); q = q * t + 0.127414796f; q = q * t;
    const f32x2 sq = (v * v) * (-0.72134752044f);
    f32x2 e; e.x = __builtin_amdgcn_exp2f(sq.x); e.y = __builtin_amdgcn_exp2f(sq.y);
    const f32x2 m = v * (q * e), r = v - m;
    f32x2 o; o.x = v.x < 0.f ? m.x : r.x; o.y = v.y < 0.f ? m.y : r.y; return o;
}
__host__ __device__ __forceinline__ int perm32(int rho) { const int n = rho >> 4, i = rho & 15; return 8 * (i >> 2) + 4 * n + (i & 3); }
__device__ __forceinline__ int otid() { int t = threadIdx.x; asm volatile("" : "+v"(t)); return t; }
__device__ __forceinline__ int obid() { int t = (int)blockIdx.x; asm volatile("" : "+s"(t)); return t; }
__device__ __forceinline__ int ogdim() { int t = (int)gridDim.x; asm volatile("" : "+s"(t)); return t; }
#define MF(x, y, acc) __builtin_amdgcn_mfma_f32_16x16x32_bf16((x), (y), (acc), 0, 0, 0)

namespace pg8 {
constexpr int BM = 256, BK = 64, HALF = 128, HTB = HALF * BK * 2, STAGE_BYTES = 8 * HTB, NXCD = 8, WGM = 8;
__host__ __device__ __forceinline__ int lds_byte(int r, int c) { const int st = (r >> 4) * 2 + (c >> 5), rr = r & 15, cc = c & 31, ob = rr * 64 + cc * 2; return st * 1024 + (ob ^ (((ob >> 9) & 1) << 5)); }
__host__ __device__ __forceinline__ void stage_rc(int b, int& R, int& C) { const int st = b / 1024, sb = b % 1024, swz = sb ^ (((sb >> 9) & 1) << 5); R = (st >> 1) * 16 + swz / 64; C = (st & 1) * 32 + (swz % 64) / 2; }
struct Unit { int pm, pn; };
struct Gemm { const bf16_t* A; const bf16_t* Bt; int M, N, K, lda; };
struct StaticOrder {
    int nM, nN, nwg, G, c;
    __host__ __device__ void init(int M, int N, int G_, int c_) { nM = M / BM; nN = N / BM; nwg = nM * nN; G = G_; c = c_; }
    __host__ __device__ bool next(int i, Unit& u) const {
        const long L = (long)i * G + c; if (L >= nwg) return false;
        int wgid = (int)L; { const int q = nwg / NXCD, r = nwg % NXCD, xcd = wgid % NXCD, off = wgid / NXCD; wgid = (xcd < r ? xcd * (q + 1) : r * (q + 1) + (xcd - r) * q) + off; }
        const int nig = WGM * nN, gid = wgid / nig, fm = gid * WGM, gsz = (nM - fm) < WGM ? (nM - fm) : WGM;
        u.pm = fm + ((wgid % nig) % gsz); u.pn = (wgid % nig) / gsz; return true;
    }
};

template <class Epi>
__device__ __forceinline__ void gemm_phase(LAS unsigned char* lds, const Gemm g, const StaticOrder& S, const Epi& E) {
    const int tid = otid(), wid = __builtin_amdgcn_readfirstlane(tid >> 6), lane = tid & 63, wr = wid >> 2, wc = wid & 3, fr = lane & 15, fq = lane >> 4;
    const int K = g.K, nt = K / BK, lda = g.lda;
    unsigned voffA[2], voffB[2];
#pragma unroll
    for (int i = 0; i < 2; ++i) { int R, C; stage_rc(tid * 16 + i * 8192, R, C);
        voffA[i] = (unsigned)(R * lda + C) * 2u; voffB[i] = (unsigned)(R * K + C) * 2u; }
    const size_t kstep = (size_t)(BK * 2);
    const size_t hstepA = (size_t)HALF * lda * 2, hstepB = (size_t)HALF * K * 2;
    const size_t tstepA = 2 * hstepA, tstepB = 2 * hstepB;
    const unsigned ldsw = (unsigned)wid * 1024u;
    const int aoff = lds_byte(wr * 64 + fr, fq * 8), boff = lds_byte(wc * 32 + fr, fq * 8);
#define PG8_SA(b, h) (((b) * 2 + (h)) * HTB)
#define PG8_SB(b, h) ((4 + (b) * 2 + (h)) * HTB)
#define PG8_STAGE(bufoff, gbase, voff) do { _Pragma("unroll") for (int _i = 0; _i < 2; ++_i) \
        __builtin_amdgcn_global_load_lds((const unsigned*)((const char*)(gbase) + (voff)[_i]), (LAS unsigned*)(lds + (bufoff) + ldsw + _i * 8192), 16, 0, 0); } while (0)
#define PG8_LDA(dst, b, h) do { _Pragma("unroll") for (int m = 0; m < 4; ++m) _Pragma("unroll") for (int k = 0; k < 2; ++k) dst[m][k] = *(const LAS bf16x8*)(lds + PG8_SA(b, h) + aoff + m * 2048 + k * 1024); } while (0)
#define PG8_LDB(dst, b, h) do { _Pragma("unroll") for (int n = 0; n < 2; ++n) _Pragma("unroll") for (int k = 0; k < 2; ++k) dst[n][k] = *(const LAS bf16x8*)(lds + PG8_SB(b, h) + boff + n * 2048 + k * 1024); } while (0)
#define PG8_MMA(ai, bj, At, Bt) do { __builtin_amdgcn_s_setprio(1); _Pragma("unroll") for (int m = 0; m < 4; ++m) _Pragma("unroll") for (int n = 0; n < 2; ++n) _Pragma("unroll") for (int k = 0; k < 2; ++k) \
        acc[ai][bj][m][n] = __builtin_amdgcn_mfma_f32_16x16x32_bf16(Bt[n][k], At[m][k], acc[ai][bj][m][n], 0, 0, 0); __builtin_amdgcn_s_setprio(0); } while (0)
#define PG8_WAIT_V(n) asm volatile("s_waitcnt vmcnt(" #n ")" ::: "memory")
#define PG8_WAIT_L(n) asm volatile("s_waitcnt lgkmcnt(" #n ")" ::: "memory")
#define PG8_BAR __builtin_amdgcn_s_barrier()
#define PG8_SCHED __builtin_amdgcn_sched_barrier(0)
    Unit cur, nxt; int ui = 0;
    if (!S.next(0, cur)) return;
    f32x4 acc[2][2][4][2];
#pragma unroll
    for (int a = 0; a < 2; ++a)
#pragma unroll
        for (int b = 0; b < 2; ++b)
#pragma unroll
            for (int m = 0; m < 4; ++m)
#pragma unroll
                for (int n = 0; n < 2; ++n) acc[a][b][m][n] = (f32x4){0.f, 0.f, 0.f, 0.f};
    bf16x8 At[4][2], B0[2][2], B1[2][2];
    const char* cA = (const char*)g.A + (size_t)cur.pm * tstepA; const char* cB = (const char*)g.Bt + (size_t)cur.pn * tstepB;
    PG8_STAGE(PG8_SB(0, 0), cB, voffB); PG8_STAGE(PG8_SA(0, 0), cA, voffA); PG8_STAGE(PG8_SB(0, 1), cB + hstepB, voffB); PG8_STAGE(PG8_SA(0, 1), cA + hstepA, voffA);
    if (wr == 1) PG8_BAR;
    PG8_WAIT_V(4); PG8_BAR;
    PG8_STAGE(PG8_SB(1, 0), cB + kstep, voffB); PG8_STAGE(PG8_SA(1, 0), cA + kstep, voffA); PG8_STAGE(PG8_SB(1, 1), cB + hstepB + kstep, voffB);
    PG8_WAIT_V(6); PG8_BAR;
    for (;;) {
        const bool has_next = S.next(ui + 1, nxt);
        const char* nA = has_next ? (const char*)g.A + (size_t)nxt.pm * tstepA : cA; const char* nB = has_next ? (const char*)g.Bt + (size_t)nxt.pn * tstepB : cB;
        for (int t = 0; t < nt; t += 2) {
            const bool last = (t == nt - 2);
            const char* a1 = cA + (size_t)(t + 1) * kstep;
            const char* a2 = last ? nA : cA + (size_t)(t + 2) * kstep; const char* b2 = last ? nB : cB + (size_t)(t + 2) * kstep;
            const char* a3 = a2 + kstep; const char* b3 = b2 + kstep;
            PG8_LDB(B0, 0, 0); PG8_SCHED; PG8_LDA(At, 0, 0); PG8_STAGE(PG8_SA(1, 1), a1 + hstepA, voffA);
            PG8_WAIT_L(8); PG8_BAR; PG8_WAIT_L(0); PG8_MMA(0, 0, At, B0); PG8_BAR; PG8_SCHED;
            PG8_LDB(B1, 0, 1); PG8_STAGE(PG8_SB(0, 0), b2, voffB);
            PG8_BAR; PG8_WAIT_L(0); PG8_MMA(0, 1, At, B1); PG8_BAR;
            PG8_LDA(At, 0, 1); PG8_STAGE(PG8_SA(0, 0), a2, voffA);
            PG8_BAR; PG8_WAIT_L(0); PG8_MMA(1, 0, At, B0); PG8_BAR; PG8_SCHED;
            PG8_STAGE(PG8_SB(0, 1), b2 + hstepB, voffB);
            PG8_WAIT_V(6); PG8_BAR; PG8_MMA(1, 1, At, B1); PG8_BAR;
            PG8_LDB(B0, 1, 0); PG8_SCHED; PG8_LDA(At, 1, 0); PG8_STAGE(PG8_SA(0, 1), a2 + hstepA, voffA);
            PG8_WAIT_L(8); PG8_BAR; PG8_WAIT_L(0); PG8_MMA(0, 0, At, B0); PG8_BAR; PG8_SCHED;
            PG8_LDB(B1, 1, 1); PG8_STAGE(PG8_SB(1, 0), b3, voffB);
            PG8_BAR; PG8_WAIT_L(0); PG8_MMA(0, 1, At, B1); PG8_BAR;
            PG8_LDA(At, 1, 1); PG8_STAGE(PG8_SA(1, 0), a3, voffA);
            PG8_BAR; PG8_WAIT_L(0); PG8_MMA(1, 0, At, B0); PG8_BAR; PG8_SCHED;
            PG8_STAGE(PG8_SB(1, 1), b3 + hstepB, voffB);
            PG8_WAIT_V(6); PG8_BAR; PG8_MMA(1, 1, At, B1); PG8_BAR;
        }
        E(acc, cur, wr, wc, fr, fq);
        if (!has_next) break;
#pragma unroll
        for (int a = 0; a < 2; ++a)
#pragma unroll
            for (int b = 0; b < 2; ++b)
#pragma unroll
                for (int m = 0; m < 4; ++m)
#pragma unroll
                    for (int n = 0; n < 2; ++n) acc[a][b][m][n] = (f32x4){0.f, 0.f, 0.f, 0.f};
        cur = nxt; cA = nA; cB = nB; ++ui;
    }
    PG8_WAIT_V(0);
    if (wr == 0) PG8_BAR;
    PG8_BAR;
#undef PG8_SA
#undef PG8_SB
#undef PG8_STAGE
#undef PG8_LDA
#undef PG8_LDB
#undef PG8_MMA
#undef PG8_WAIT_V
#undef PG8_WAIT_L
#undef PG8_BAR
#undef PG8_SCHED
}
}

struct EpiF32 {
    float* C; int ldc;
    __device__ __forceinline__ void operator()(const f32x4 (&acc)[2][2][4][2], const pg8::Unit& u, int wr, int wc, int fr, int fq) const {
        const int row0 = u.pm * 256 + wr * 64 + fr, col0 = u.pn * 256 + wc * 32 + 4 * fq;
#pragma unroll
        for (int ai = 0; ai < 2; ++ai)
#pragma unroll
            for (int m = 0; m < 4; ++m) { float* rowp = C + (size_t)(row0 + ai * 128 + m * 16) * ldc + col0;
#pragma unroll
                for (int bj = 0; bj < 2; ++bj)
#pragma unroll
                    for (int n = 0; n < 2; ++n) *(f32x4*)(rowp + bj * 128 + n * 16) = acc[ai][bj][m][n]; }
    }
};
struct EpiBf16Y {
    bf16_t* O;
    __device__ __forceinline__ void operator()(const f32x4 (&acc)[2][2][4][2], const pg8::Unit& u, int wr, int wc, int fr, int fq) const {
        const int row0 = u.pm * 256 + wr * 64 + fr, col0 = u.pn * 256 + wc * 32 + 8 * fq;
#pragma unroll
        for (int ai = 0; ai < 2; ++ai)
#pragma unroll
            for (int m = 0; m < 4; ++m) { bf16_t* rowp = O + (size_t)(row0 + ai * 128 + m * 16) * DM + col0;
#pragma unroll
                for (int bj = 0; bj < 2; ++bj) { const f32x4 v0 = acc[ai][bj][m][0], v1 = acc[ai][bj][m][1];
                    u32x4 w; w.x = cvt_pk_bf16(v0[0], v0[1]); w.y = cvt_pk_bf16(v0[2], v0[3]); w.z = cvt_pk_bf16(v1[0], v1[1]); w.w = cvt_pk_bf16(v1[2], v1[3]);
                    *(u32x4*)(rowp + bj * 128) = w; } }
    }
};
struct EpiSwiGLU {
    bf16_t* O;
    __device__ __forceinline__ void operator()(const f32x4 (&acc)[2][2][4][2], const pg8::Unit& u, int wr, int wc, int fr, int fq) const {
        const int row0 = u.pm * 256 + wr * 64 + fr, col0 = u.pn * 128 + wc * 32 + 8 * fq;
#pragma unroll
        for (int ai = 0; ai < 2; ++ai)
#pragma unroll
            for (int m = 0; m < 4; ++m) {
                float v[8];
#pragma unroll
                for (int n = 0; n < 2; ++n)
#pragma unroll
                    for (int j = 0; j < 4; ++j) v[n * 4 + j] = silu_f(acc[ai][0][m][n][j]) * acc[ai][1][m][n][j];
                u32x4 w; w.x = cvt_pk_bf16(v[0], v[1]); w.y = cvt_pk_bf16(v[2], v[3]); w.z = cvt_pk_bf16(v[4], v[5]); w.w = cvt_pk_bf16(v[6], v[7]);
                *(u32x4*)(O + (size_t)(row0 + ai * 128 + m * 16) * FF + col0) = w;
            }
    }
};
struct EpiDnIn {
    bf16_t* QKV; bf16_t* Z; float* BA; bf16_t* HALO;
    __device__ __forceinline__ void operator()(const f32x4 (&acc)[2][2][4][2], const pg8::Unit& u, int wr, int wc, int fr, int fq) const {
        const int row0 = u.pm * 256 + wr * 64 + fr;
#pragma unroll
        for (int ai = 0; ai < 2; ++ai)
#pragma unroll
            for (int m = 0; m < 4; ++m) {
                const int r = row0 + ai * 128 + m * 16;
#pragma unroll
                for (int bj = 0; bj < 2; ++bj) {
                    const int c0 = u.pn * 256 + bj * 128 + wc * 32 + 8 * fq;
                    const f32x4 v0 = acc[ai][bj][m][0], v1 = acc[ai][bj][m][1];
                    if (u.pn < 16) {
                        u32x4 w; w.x = cvt_pk_bf16(v0[0], v0[1]); w.y = cvt_pk_bf16(v0[2], v0[3]); w.z = cvt_pk_bf16(v1[0], v1[1]); w.w = cvt_pk_bf16(v1[2], v1[3]);
                        if (u.pn < 12) {
                            *(u32x4*)(QKV + (size_t)r * 3072 + c0) = w;
                            const int rl = r & 63;
                            if (rl >= 61) *(u32x4*)(HALO + ((size_t)(r >> 6) * 3 + (rl - 61)) * 3072 + c0) = w;
                        } else *(u32x4*)(Z + (size_t)r * 1024 + (c0 - 3072)) = w;
                    } else if (c0 < 4112) { *(f32x4*)(BA + (size_t)r * 16 + (c0 - 4096)) = v0; *(f32x4*)(BA + (size_t)r * 16 + (c0 - 4096) + 4) = v1; }
                }
            }
    }
};
struct EpiSgIn {
    bf16_t* U; bf16_t* V; const float* bias;
    __device__ __forceinline__ void operator()(const f32x4 (&acc)[2][2][4][2], const pg8::Unit& u, int wr, int wc, int fr, int fq) const {
        const int row0 = u.pm * 256 + wr * 64 + fr;
        bf16_t* base = u.pn < 8 ? U : V;
        const int cb = (u.pn < 8 ? u.pn : u.pn - 8) * 256;
        f32x4 bv[2][2];
#pragma unroll
        for (int bj = 0; bj < 2; ++bj)
#pragma unroll
            for (int n = 0; n < 2; ++n) bv[bj][n] = *(const f32x4*)(bias + u.pn * 256 + bj * 128 + wc * 32 + 8 * fq + 4 * n);
#pragma unroll
        for (int ai = 0; ai < 2; ++ai)
#pragma unroll
            for (int m = 0; m < 4; ++m) {
                const int r = row0 + ai * 128 + m * 16;
#pragma unroll
                for (int bj = 0; bj < 2; ++bj) {
                    const int c0 = cb + bj * 128 + wc * 32 + 8 * fq;
                    const f32x4 v0 = acc[ai][bj][m][0] + bv[bj][0], v1 = acc[ai][bj][m][1] + bv[bj][1];
                    const f32x2 ga = gelu_pk((f32x2){v0[0], v0[1]}), gb = gelu_pk((f32x2){v0[2], v0[3]}), gc = gelu_pk((f32x2){v1[0], v1[1]}), gd = gelu_pk((f32x2){v1[2], v1[3]});
                    u32x4 w; w.x = cvt_pk_bf16(ga.x, ga.y); w.y = cvt_pk_bf16(gb.x, gb.y); w.z = cvt_pk_bf16(gc.x, gc.y); w.w = cvt_pk_bf16(gd.x, gd.y);
                    *(u32x4*)(base + (size_t)r * 2048 + c0) = w;
                }
            }
    }
};

template <class Epi>
__device__ __forceinline__ void run_gemm(LAS unsigned char* lds, const bf16_t* A, int lda, const bf16_t* Bt, int M, int N, int K, const Epi& E) {
    pg8::Gemm g; g.A = A; g.Bt = Bt; g.M = M; g.N = N; g.K = K; g.lda = lda;
    pg8::StaticOrder S; S.init(M, N, (int)ogdim(), obid());
    pg8::gemm_phase<Epi>(lds, g, S, E);
}

constexpr int PREP_EARLY = 1728, PREP_TOTAL = 5664;
__device__ __forceinline__ int prep_unit_of(int v) {
    if (v < 704) return v; if (v < 1056) return 2816 + (v - 704); if (v < 1728) return 4224 + (v - 1056);
    const int w = v - 1728; if (w < 2112) return 704 + w; if (w < 3168) return 3168 + (w - 2112); return 4896 + (w - 3168);
}
__device__ __forceinline__ void prep_weights(const Params& p, LAS unsigned char* lds, int v_begin, int v_end, int worker, int n_workers) {
    LAS float* tile = (LAS float*)lds;
    const int tid = otid();
    for (int vu = v_begin + worker; vu < v_end; vu += n_workers) {
        int uu = prep_unit_of(vu), K, ldn, ncols; const float* src; bf16_t* dst; bool perm; int g2, kt;
        if (uu < 2816) { const int i = uu / 704; uu -= i * 704; K = 1024; g2 = uu >> 3; kt = uu & 7;
            const int g = 2 * g2, pn = g >> 3, bj = (g >> 2) & 1, wc = g & 3;
            src = (bj ? p.w_up : p.w_gate) + (size_t)i * 1024 * 2816 + (128 * pn + 32 * wc); ldn = 2816; ncols = 64; perm = true;
            dst = (bf16_t*)(p.ws + OFF_WGU + i * SZ_WGU);
        } else if ((uu -= 2816) < 1408) { const int i = uu / 352; uu -= i * 352; K = 2816; g2 = uu / 22; kt = uu % 22;
            src = p.w_down + (size_t)i * 2816 * 1024 + 64 * g2; ldn = 1024; ncols = 64; perm = true; dst = (bf16_t*)(p.ws + OFF_WD + i * SZ_WD);
        } else if ((uu -= 1408) < 544) { K = 1024; g2 = uu >> 3; kt = uu & 7; src = p.dn_w_in + 64 * g2; ldn = 4112; ncols = 4112 - 64 * g2; perm = true; dst = (bf16_t*)(p.ws + OFF_WDNIN);
        } else if ((uu -= 544) < 128) { K = 1024; g2 = uu >> 3; kt = uu & 7; src = p.dn_w_out + 64 * g2; ldn = 1024; ncols = 64; perm = true; dst = (bf16_t*)(p.ws + OFF_WDNOUT);
        } else if ((uu -= 128) < 512) { K = 1024; g2 = uu >> 3; kt = uu & 7; src = p.sg_w_in + 64 * g2; ldn = 4096; ncols = 64; perm = true; dst = (bf16_t*)(p.ws + OFF_WSGIN);
        } else { uu -= 512; K = 2048; g2 = uu >> 4; kt = uu & 15; src = p.sg_w_out + 64 * g2; ldn = 1024; ncols = 64; perm = true; dst = (bf16_t*)(p.ws + OFF_WSGOUT); }
        const int c4 = (tid & 15) * 4, k0 = tid >> 4, kb = kt * 128;
#pragma unroll
        for (int it = 0; it < 4; ++it) { const int k = k0 + 32 * it;
            f32x4 v = (f32x4){0.f, 0.f, 0.f, 0.f};
            if (c4 < ncols) v = *(const f32x4*)(src + (size_t)(kb + k) * ldn + c4);
            tile[k * 65 + c4] = v[0]; tile[k * 65 + c4 + 1] = v[1]; tile[k * 65 + c4 + 2] = v[2]; tile[k * 65 + c4 + 3] = v[3]; }
        __syncthreads();
#pragma unroll
        for (int it = 0; it < 2; ++it) {
            const int rho = (tid >> 4) + 32 * it, kseg = tid & 15, sc = (rho & 32) + (perm ? perm32(rho & 31) : (rho & 31));
            float v[8];
#pragma unroll
            for (int i = 0; i < 8; ++i) v[i] = tile[(kseg * 8 + i) * 65 + sc];
            u32x4 w; w.x = cvt_pk_bf16(v[0], v[1]); w.y = cvt_pk_bf16(v[2], v[3]); w.z = cvt_pk_bf16(v[4], v[5]); w.w = cvt_pk_bf16(v[6], v[7]);
            *(u32x4*)(dst + (size_t)(g2 * 64 + rho) * K + kb + kseg * 8) = w;
        }
        __syncthreads();
    }
    if (v_begin != 0) return;
    bf16_t* Ws = (bf16_t*)(p.ws + OFF_WS);
    for (int i = obid() * NTHR + tid; i < 8 * 128 * 128 / 2; i += ogdim() * NTHR) {
        const int e = i * 2, s = e & 127, t = (e >> 7) & 127;
        const f32x2 v = *(const f32x2*)(p.sg_w_s + e);
        ((unsigned*)Ws)[i] = cvt_pk_bf16(s <= t ? v.x : 0.f, (s + 1) <= t ? v.y : 0.f);
    }
}

__device__ __forceinline__ void phase_rowwise(const float* xin, float* xout, const bf16_t* y, const float* g_post, float coef, const float* g_pre, bf16_t* h) {
    const int tid_ = otid(), wid = tid_ >> 6, lane = tid_ & 63;
    for (int row0 = (obid() * 8 + wid) * 2; row0 < T; row0 += ogdim() * 16) {
        f32x4 xv[2][4]; u32x2 yv[2][4];
#pragma unroll
        for (int r = 0; r < 2; ++r)
#pragma unroll
            for (int i = 0; i < 4; ++i) { xv[r][i] = *(const f32x4*)(xin + (size_t)(row0 + r) * DM + i * 256 + lane * 4);
                if (y) yv[r][i] = *(const u32x2*)(y + (size_t)(row0 + r) * DM + i * 256 + lane * 4); }
        if (y) {
            float ss[2] = {0.f, 0.f}; f32x4 yf[2][4];
#pragma unroll
            for (int r = 0; r < 2; ++r)
#pragma unroll
                for (int i = 0; i < 4; ++i) { yf[r][i] = (f32x4){bf_lo(yv[r][i].x), bf_hi(yv[r][i].x), bf_lo(yv[r][i].y), bf_hi(yv[r][i].y)};
                    ss[r] += yf[r][i][0] * yf[r][i][0] + yf[r][i][1] * yf[r][i][1] + yf[r][i][2] * yf[r][i][2] + yf[r][i][3] * yf[r][i][3]; }
#pragma unroll
            for (int o = 32; o >= 1; o >>= 1) { ss[0] += __shfl_xor(ss[0], o); ss[1] += __shfl_xor(ss[1], o); }
#pragma unroll
            for (int r = 0; r < 2; ++r) { const float rs = rsqrtf(ss[r] * (1.0f / DM) + 1e-6f) * coef;
#pragma unroll
                for (int i = 0; i < 4; ++i) { const f32x4 gp = *(const f32x4*)(g_post + i * 256 + lane * 4); xv[r][i] += yf[r][i] * gp * rs; } }
        }
        if (xout) {
#pragma unroll
            for (int r = 0; r < 2; ++r)
#pragma unroll
                for (int i = 0; i < 4; ++i) *(f32x4*)(xout + (size_t)(row0 + r) * DM + i * 256 + lane * 4) = xv[r][i];
        }
        if (g_pre) {
            float ss[2] = {0.f, 0.f};
#pragma unroll
            for (int r = 0; r < 2; ++r)
#pragma unroll
                for (int i = 0; i < 4; ++i) ss[r] += xv[r][i][0] * xv[r][i][0] + xv[r][i][1] * xv[r][i][1] + xv[r][i][2] * xv[r][i][2] + xv[r][i][3] * xv[r][i][3];
#pragma unroll
            for (int o = 32; o >= 1; o >>= 1) { ss[0] += __shfl_xor(ss[0], o); ss[1] += __shfl_xor(ss[1], o); }
#pragma unroll
            for (int r = 0; r < 2; ++r) { const float rs = rsqrtf(ss[r] * (1.0f / DM) + 1e-6f);
#pragma unroll
                for (int i = 0; i < 4; ++i) { const f32x4 gp = *(const f32x4*)(g_pre + i * 256 + lane * 4); const f32x4 hv = xv[r][i] * gp * rs;
                    u32x2 w; w.x = cvt_pk_bf16(hv[0], hv[1]); w.y = cvt_pk_bf16(hv[2], hv[3]);
                    *(u32x2*)(h + (size_t)(row0 + r) * DM + i * 256 + lane * 4) = w; } }
        }
    }
}

constexpr int QS_LD = 136, XT_LD = 72;
constexpr int L_LM = 0, L_SC = L_LM + 64 * 64 * 4, L_QS = L_SC + 5 * 64 * 4, L_KS = L_QS + 64 * QS_LD * 2, L_VS = L_KS + 64 * QS_LD * 2, L_AT = L_VS + 64 * QS_LD * 2,
              L_XT = L_AT + 64 * XT_LD * 2, L_KD = L_XT + 256 * XT_LD * 2, L_LB = L_KD + 128 * XT_LD * 2, L_SCR = L_LB + 64 * XT_LD * 2, L_D1END = L_SCR + 16 * 256 * 4;
static_assert(L_D1END <= 160 * 1024, "LDS");

__device__ __forceinline__ bf16x8 lds_frag(LAS unsigned char* base, int ld_elems, int r0, int k0, int fr, int fq) {
    return *(const LAS bf16x8*)(base + ((r0 + fr) * ld_elems + k0 + 8 * fq) * 2);
}

#define RELAUNDER() const int tid = otid(), wid = tid >> 6, lane = tid & 63, fr = lane & 15, fq = lane >> 4; (void)wid; (void)lane; (void)fr; (void)fq
__device__ __forceinline__ void phase_dn_local(const Params& p, int half, LAS unsigned char* lds, bool dry) {
    bf16_t* QKV = (bf16_t*)(p.ws + OFF_QKV); const bf16_t* HALO = (const bf16_t*)(p.ws + OFF_HALO); const float* BA = (const float*)(p.ws + OFF_BA);
    bf16_t* Pg = (bf16_t*)(p.ws + OFF_P); bf16_t* Ng = (bf16_t*)(p.ws + OFF_N); float* GL = (float*)(p.ws + OFF_GL);
    LAS float* sc_gc = (LAS float*)(lds + L_SC); LAS float* sc_beta = sc_gc + 64; LAS float* sc_egc = sc_gc + 128; LAS float* sc_ekd = sc_gc + 192;
    LAS float* Lm = (LAS float*)(lds + L_LM);
    u32x4 xr[3][4][2]; float braw_n = 0.f, araw_n = 0.f; f32x4 cwv = (f32x4){0.f, 0.f, 0.f, 0.f};
#define D1_LOAD(ITEM) do { const int it_ = (ITEM); if (it_ < 2048) { const int lt_ = otid(); \
        const int n_ = it_ & 127, h_ = (it_ >> 7) & 7, b_ = half * 2 + (it_ >> 10), t0_ = b_ * SEQ + n_ * 64, row_ = lt_ >> 3, seg_ = lt_ & 7; \
        if (lt_ < 64) { braw_n = BA[(size_t)(t0_ + lt_) * 16 + h_]; araw_n = BA[(size_t)(t0_ + lt_) * 16 + 8 + h_]; } \
        if (lt_ >= 128) { const int e_ = (lt_ - 128) * 4; cwv = *(const f32x4*)(p.dn_conv_w + ((e_ >> 7) & 3) * 3072 + (e_ >> 9) * 1024 + h_ * 128 + (e_ & 127)); } \
        _Pragma("unroll") for (int part = 0; part < 3; ++part) _Pragma("unroll") for (int j = 0; j < 4; ++j) { \
            const int rr = row_ - 3 + j, cb = part * 1024 + h_ * 128 + seg_ * 16; \
            const bf16_t* src = (rr >= 0) ? QKV + (size_t)(t0_ + rr) * 3072 + cb : HALO + ((size_t)((n_ > 0 ? (t0_ >> 6) - 1 : 0)) * 3 + (rr + 3)) * 3072 + cb; \
            xr[part][j][0] = *(const u32x4*)src; xr[part][j][1] = *(const u32x4*)(src + 8); \
            if (rr < 0 && n_ == 0) { xr[part][j][0] = (u32x4){0u, 0u, 0u, 0u}; xr[part][j][1] = xr[part][j][0]; } } } } while (0)
    D1_LOAD(obid());
    for (int item = obid(); item < 2048; item += ogdim()) {
        const int n = item & 127, h = (item >> 7) & 7, bl = item >> 10, b = half * 2 + bl;
        const int t0 = b * SEQ + n * 64;
        const float braw = braw_n, araw = araw_n;
        {
            const int t = otid();
            if (t >= 128) *(LAS f32x4*)(lds + L_SCR + (t - 128) * 16) = cwv;
        }
        __syncthreads();
        {
            RELAUNDER();
            { LAS unsigned char* zp = lds + L_XT + (tid >> 1) * XT_LD * 2 + (tid & 1) * 64; const u32x4 z = (u32x4){0u, 0u, 0u, 0u};
              *(LAS u32x4*)zp = z; *(LAS u32x4*)(zp + 16) = z; *(LAS u32x4*)(zp + 32) = z; *(LAS u32x4*)(zp + 48) = z; }
            const int row = tid >> 3, seg = tid & 7;
#pragma unroll
            for (int part = 0; part < 3; ++part) {
                float a[16];
#pragma unroll
                for (int c = 0; c < 16; ++c) a[c] = 0.f;
#pragma unroll
                for (int j = 0; j < 4; ++j) {
                    const u32x4 x0 = xr[part][j][0], x1 = xr[part][j][1];
                    const LAS float* wj = (const LAS float*)(lds + L_SCR) + (part * 4 + j) * 128 + seg * 16;
                    const f32x4 w0 = *(const LAS f32x4*)wj, w1 = *(const LAS f32x4*)(wj + 4), w2 = *(const LAS f32x4*)(wj + 8), w3 = *(const LAS f32x4*)(wj + 12);
                    a[0] += w0[0] * bf_lo(x0.x); a[1] += w0[1] * bf_hi(x0.x); a[2] += w0[2] * bf_lo(x0.y); a[3] += w0[3] * bf_hi(x0.y);
                    a[4] += w1[0] * bf_lo(x0.z); a[5] += w1[1] * bf_hi(x0.z); a[6] += w1[2] * bf_lo(x0.w); a[7] += w1[3] * bf_hi(x0.w);
                    a[8] += w2[0] * bf_lo(x1.x); a[9] += w2[1] * bf_hi(x1.x); a[10] += w2[2] * bf_lo(x1.y); a[11] += w2[3] * bf_hi(x1.y);
                    a[12] += w3[0] * bf_lo(x1.z); a[13] += w3[1] * bf_hi(x1.z); a[14] += w3[2] * bf_lo(x1.w); a[15] += w3[3] * bf_hi(x1.w);
                }
                float ss = 0.f;
#pragma unroll
                for (int c = 0; c < 16; ++c) { a[c] = silu_f(a[c]); ss += a[c] * a[c]; }
                float scl = 1.0f;
                if (part < 2) {
                    ss += __shfl_xor(ss, 1); ss += __shfl_xor(ss, 2); ss += __shfl_xor(ss, 4);
                    scl = rsqrtf(ss + 1e-6f) * (part == 0 ? 0.08838834764831845f : 1.0f);
                }
                u32x4 o0, o1;
                o0.x = cvt_pk_bf16(a[0] * scl, a[1] * scl); o0.y = cvt_pk_bf16(a[2] * scl, a[3] * scl); o0.z = cvt_pk_bf16(a[4] * scl, a[5] * scl); o0.w = cvt_pk_bf16(a[6] * scl, a[7] * scl);
                o1.x = cvt_pk_bf16(a[8] * scl, a[9] * scl); o1.y = cvt_pk_bf16(a[10] * scl, a[11] * scl); o1.z = cvt_pk_bf16(a[12] * scl, a[13] * scl); o1.w = cvt_pk_bf16(a[14] * scl, a[15] * scl);
                LAS unsigned char* dstp = lds + (part == 0 ? L_QS : part == 1 ? L_KS : L_VS) + (row * QS_LD + seg * 16) * 2;
                *(LAS u32x4*)dstp = o0; *(LAS u32x4*)(dstp + 16) = o1;
            }
        }
        D1_LOAD(item + ogdim());
        if (otid() < 64) {
            const int lane = otid() & 63;
            const float beta = 1.0f / (1.0f + __expf(-braw));
            const float xx = araw + p.dn_dt_bias[h];
            const float sp = fmaxf(xx, 0.f) + log1pf(__expf(-fabsf(xx)));
            float g = -__expf(p.dn_a_log[h]) * sp;
#pragma unroll
            for (int o = 1; o < 64; o <<= 1) { const float t = __shfl_up(g, o); if (lane >= o) g += t; }
            const float glast = __shfl(g, 63);
            sc_gc[lane] = g; sc_beta[lane] = beta; sc_egc[lane] = __expf(g); sc_ekd[lane] = __expf(glast - g);
            if (lane == 0) GL[(b * 8 + h) * 128 + n] = __expf(glast);
        }
        __syncthreads();
        {
            RELAUNDER();
            const int kind = wid >> 2, fi = wid & 3;
            const int i = 16 * fi + fr; const float gci = sc_gc[i], bi = sc_beta[i];
            bf16x8 yf[4];
#pragma unroll
            for (int ks = 0; ks < 4; ++ks) yf[ks] = lds_frag(lds + (kind ? L_QS : L_KS), QS_LD, 16 * fi, 32 * ks, fr, fq);
            for (int fj = 0; fj < 4; ++fj) {
                f32x4 acc = (f32x4){0.f, 0.f, 0.f, 0.f};
                if (fj <= fi) {
#pragma unroll
                    for (int ks = 0; ks < 4; ++ks) acc = MF(lds_frag(lds + L_KS, QS_LD, 16 * fj, 32 * ks, fr, fq), yf[ks], acc);
                }
                const int j0 = 16 * fj + 4 * fq;
                float v[4];
#pragma unroll
                for (int r = 0; r < 4; ++r) { const int j = j0 + r; const bool keep = kind ? (j <= i) : (j < i);
                    v[r] = keep ? acc[r] * __expf(gci - sc_gc[j]) * (kind ? 1.0f : bi) : 0.f; }
                if (kind == 0) { *(LAS f32x4*)(Lm + i * 64 + j0) = (f32x4){v[0], v[1], v[2], v[3]};
                    u32x2 w; w.x = cvt_pk_bf16(v[0], v[1]); w.y = cvt_pk_bf16(v[2], v[3]); *(LAS u32x2*)(lds + L_LB + (i * XT_LD + j0) * 2) = w; }
                else { u32x2 w; w.x = cvt_pk_bf16(v[0], v[1]); w.y = cvt_pk_bf16(v[2], v[3]); *(LAS u32x2*)(lds + L_AT + (i * XT_LD + j0) * 2) = w; }
            }
            const int dk = tid & 127, cq = tid >> 7;
            float kv[16];
#pragma unroll
            for (int c = 0; c < 16; ++c) kv[c] = bf2f(*(const LAS bf16_t*)(lds + L_KS + ((16 * cq + c) * QS_LD + dk) * 2)) * sc_ekd[16 * cq + c];
            u32x4 o0, o1;
            o0.x = cvt_pk_bf16(kv[0], kv[1]); o0.y = cvt_pk_bf16(kv[2], kv[3]); o0.z = cvt_pk_bf16(kv[4], kv[5]); o0.w = cvt_pk_bf16(kv[6], kv[7]);
            o1.x = cvt_pk_bf16(kv[8], kv[9]); o1.y = cvt_pk_bf16(kv[10], kv[11]); o1.z = cvt_pk_bf16(kv[12], kv[13]); o1.w = cvt_pk_bf16(kv[14], kv[15]);
            LAS unsigned char* dstp = lds + L_KD + (dk * XT_LD + 16 * cq) * 2;
            *(LAS u32x4*)dstp = o0; *(LAS u32x4*)(dstp + 16) = o1;
        }
        __syncthreads();
#pragma unroll
        for (int I = 0; I < 4; ++I) {
            if (I > 0) {
                RELAUNDER();
                LAS float* scr = (LAS float*)(lds + L_SCR);
#pragma unroll
                for (int cfi = 0; cfi < 2; ++cfi) {
                    const int c0 = 32 * wid + 16 * cfi;
                    f32x4 acc = (f32x4){0.f, 0.f, 0.f, 0.f};
#pragma unroll
                    for (int ks = 0; ks < (I == 3 ? 2 : 1); ++ks)
                        acc = MF(lds_frag(lds + L_LB, XT_LD, 16 * I, 32 * ks, fr, fq), lds_frag(lds + L_XT, XT_LD, c0, 32 * ks, fr, fq), acc);
#pragma unroll
                    for (int r = 0; r < 4; ++r) scr[(4 * fq + r) * 256 + c0 + fr] = acc[r];
                }
                __syncthreads();
            }
            if (otid() < 256) {
                RELAUNDER();
                float x[16];
                const bool isw = tid >= 128; const int cc = tid & 127;
                LAS unsigned char* srcm = lds + (isw ? L_KS : L_VS);
                const LAS float* scr = (const LAS float*)(lds + L_SCR);
#pragma unroll
                for (int r = 0; r < 16; ++r) { const int i = 16 * I + r;
                    x[r] = bf2f(*(const LAS bf16_t*)(srcm + (i * QS_LD + cc) * 2)) * sc_beta[i] * (isw ? sc_egc[i] : 1.0f);
                    if (I > 0) x[r] -= scr[r * 256 + tid]; }
#pragma unroll
                for (int r = 1; r < 16; ++r) {
                    float sacc = x[r];
#pragma unroll
                    for (int k4 = 0; k4 < (r + 3) / 4; ++k4) {
                        const f32x4 l = *(const LAS f32x4*)(Lm + (16 * I + r) * 64 + 16 * I + 4 * k4);
                        sacc -= l[0] * x[4 * k4]; sacc -= l[1] * x[4 * k4 + 1]; sacc -= l[2] * x[4 * k4 + 2]; sacc -= l[3] * x[4 * k4 + 3];
                    }
                    x[r] = sacc;
                }
                LAS unsigned char* dstp = lds + L_XT + (tid * XT_LD + 16 * I) * 2;
                u32x4 w0, w1;
                w0.x = cvt_pk_bf16(x[0], x[1]); w0.y = cvt_pk_bf16(x[2], x[3]); w0.z = cvt_pk_bf16(x[4], x[5]); w0.w = cvt_pk_bf16(x[6], x[7]);
                w1.x = cvt_pk_bf16(x[8], x[9]); w1.y = cvt_pk_bf16(x[10], x[11]); w1.z = cvt_pk_bf16(x[12], x[13]); w1.w = cvt_pk_bf16(x[14], x[15]);
                *(LAS u32x4*)dstp = w0; *(LAS u32x4*)(dstp + 16) = w1;
            }
            __syncthreads();
        }
        {
            RELAUNDER();
            LAS unsigned char* uT = lds + L_XT; LAS unsigned char* wT = lds + L_XT + 128 * XT_LD * 2; LAS unsigned char* stg = lds + L_KS;
            const int frow = tid >> 4, fc16 = (tid & 15) * 8;
            {
                const int fi = wid & 3, cf0 = (wid >> 2) * 4, i = 16 * fi + fr;
                bf16x8 af[2];
#pragma unroll
                for (int ks = 0; ks < 2; ++ks) af[ks] = lds_frag(lds + L_AT, XT_LD, 16 * fi, 32 * ks, fr, fq);
                const float egi = sc_egc[i];
#pragma unroll
                for (int cf = 0; cf < 4; ++cf) {
                    const int c0 = 16 * (cf0 + cf);
                    f32x4 aw = (f32x4){0.f, 0.f, 0.f, 0.f}, au = aw;
#pragma unroll
                    for (int ks = 0; ks < 2; ++ks) { aw = MF(lds_frag(wT, XT_LD, c0, 32 * ks, fr, fq), af[ks], aw); au = MF(lds_frag(uT, XT_LD, c0, 32 * ks, fr, fq), af[ks], au); }
                    const u32x2 qv = *(const LAS u32x2*)(lds + L_QS + (i * QS_LD + c0 + 4 * fq) * 2);
                    u32x2 wr_, wo;
                    wr_.x = cvt_pk_bf16(bf_lo(qv.x) * egi - aw[0], bf_hi(qv.x) * egi - aw[1]); wr_.y = cvt_pk_bf16(bf_lo(qv.y) * egi - aw[2], bf_hi(qv.y) * egi - aw[3]);
                    wo.x = cvt_pk_bf16(au[0], au[1]); wo.y = cvt_pk_bf16(au[2], au[3]);
                    *(LAS u32x2*)(stg + (i * QS_LD + c0 + 4 * fq) * 2) = wr_;
                    *(LAS u32x2*)(stg + ((64 + i) * QS_LD + c0 + 4 * fq) * 2) = wo;
                }
            }
            __syncthreads();
            if (!dry) {
#pragma unroll
                for (int it = 0; it < 4; ++it) { const int row = frow + 32 * it;
                    const u32x4 v = *(const LAS u32x4*)(stg + (row * QS_LD + fc16) * 2);
                    *(u32x4*)(QKV + (size_t)(t0 + (row & 63)) * 3072 + (row >> 6) * 1024 + h * 128 + fc16) = v; }
            }
            __syncthreads();
            bf16_t* Pn = Pg + (size_t)((bl * 8 + h) * 128 + n) * 16384; bf16_t* Nn = Ng + (size_t)((bl * 8 + h) * 128 + n) * 16384;
            bf16x8 kf[2], uf[2];
#pragma unroll
            for (int ks = 0; ks < 2; ++ks) { kf[ks] = lds_frag(lds + L_KD, XT_LD, 16 * wid, 32 * ks, fr, fq); uf[ks] = lds_frag(uT, XT_LD, 16 * wid, 32 * ks, fr, fq); }
#pragma unroll
            for (int cf = 0; cf < 8; ++cf) {
                f32x4 ap = (f32x4){0.f, 0.f, 0.f, 0.f};
#pragma unroll
                for (int ks = 0; ks < 2; ++ks) ap = MF(lds_frag(wT, XT_LD, 16 * cf, 32 * ks, fr, fq), kf[ks], ap);
                u32x2 w1; w1.x = cvt_pk_bf16(ap[0], ap[1]); w1.y = cvt_pk_bf16(ap[2], ap[3]);
                *(LAS u32x2*)(stg + ((16 * wid + fr) * QS_LD + 16 * cf + 4 * fq) * 2) = w1;
            }
            __syncthreads();
            if (!dry) {
#pragma unroll
                for (int it = 0; it < 4; ++it) { const int row = frow + 32 * it;
                    *(u32x4*)(Pn + row * 128 + fc16) = *(const LAS u32x4*)(stg + (row * QS_LD + fc16) * 2); }
            }
            __syncthreads();
#pragma unroll
            for (int cf = 0; cf < 8; ++cf) {
                f32x4 an = (f32x4){0.f, 0.f, 0.f, 0.f};
#pragma unroll
                for (int ks = 0; ks < 2; ++ks) an = MF(lds_frag(lds + L_KD, XT_LD, 16 * cf, 32 * ks, fr, fq), uf[ks], an);
                u32x2 w2; w2.x = cvt_pk_bf16(an[0], an[1]); w2.y = cvt_pk_bf16(an[2], an[3]);
                *(LAS u32x2*)(stg + ((16 * wid + fr) * QS_LD + 16 * cf + 4 * fq) * 2) = w2;
            }
            __syncthreads();
            if (!dry) {
#pragma unroll
                for (int it = 0; it < 4; ++it) { const int row = frow + 32 * it;
                    *(u32x4*)(Nn + row * 128 + fc16) = *(const LAS u32x4*)(stg + (row * QS_LD + fc16) * 2); }
            }
        }
    }
}

#undef D1_LOAD
__device__ __forceinline__ void phase_dn_scan(const Params& p, int half, LAS unsigned char* lds, bool dry) {
    const int tid = otid(), wid = tid >> 6, lane = tid & 63, fr = lane & 15, fq = lane >> 4;
    const bf16_t* Pg = (const bf16_t*)(p.ws + OFF_P); bf16_t* Ng = (bf16_t*)(p.ws + OFF_N); const float* GL = (const float*)(p.ws + OFF_GL);
    constexpr int ST_LD = 136;
    for (int blk = obid(); blk < 256; blk += ogdim()) {
        const int xcd = blk & 7, j = blk >> 3;
        if (j >= 16) {
            const int mid = PREP_EARLY + (PREP_TOTAL - PREP_EARLY) / 2;
            if (!dry && j < 32) prep_weights(p, lds, half ? mid : PREP_EARLY, half ? PREP_TOTAL : mid, xcd + 8 * (j - 16), 128);
            continue;
        }
        const int slice = j & 7, bh = xcd * 2 + (j >> 3), bl = bh >> 3, h = bh & 7, b = half * 2 + bl;
        const bf16_t* Pb = Pg + (size_t)((bl * 8 + h) * 128) * 16384 + (16 * wid + fr) * 128 + 8 * fq;
        bf16_t* Nb = Ng + (size_t)((bl * 8 + h) * 128) * 16384 + (slice * 16 + fr) * 128 + 16 * wid + 4 * fq;
        const float* glb = GL + (b * 8 + h) * 128;
        __syncthreads();
        float s[4] = {0.f, 0.f, 0.f, 0.f};
        *(LAS u32x2*)(lds + (fr * ST_LD + 16 * wid + 4 * fq) * 2) = (u32x2){0u, 0u};
        bf16x8 pf[4][4]; u32x2 nf[4];
        const float gla = glb[lane], glb2 = glb[64 + lane];
#define SC_LOAD(slot, nn) do { const bf16_t* pp_ = Pb + (size_t)(nn) * 16384; const bf16_t* np_ = Nb + (size_t)(nn) * 16384; \
        asm volatile("global_load_dwordx2 %0, %1, off" : "=v"(nf[slot]) : "v"(np_) : "memory"); \
        asm volatile("global_load_dwordx4 %0, %1, off" : "=v"(pf[slot][0]) : "v"(pp_) : "memory"); \
        asm volatile("global_load_dwordx4 %0, %1, off offset:64" : "=v"(pf[slot][1]) : "v"(pp_) : "memory"); \
        asm volatile("global_load_dwordx4 %0, %1, off offset:128" : "=v"(pf[slot][2]) : "v"(pp_) : "memory"); \
        asm volatile("global_load_dwordx4 %0, %1, off offset:192" : "=v"(pf[slot][3]) : "v"(pp_) : "memory"); } while (0)
#define SC_STEP(u, n, WAITSTR) do { \
            asm volatile(WAITSTR : "+v"(nf[u]), "+v"(pf[u][0]), "+v"(pf[u][1]), "+v"(pf[u][2]), "+v"(pf[u][3]) :: "memory");     \
            asm volatile("s_waitcnt lgkmcnt(0)" ::: "memory"); __builtin_amdgcn_s_barrier(); asm volatile("" ::: "memory"); \
            LAS unsigned char* stc = lds + ((n) & 1) * (16 * ST_LD * 2); LAS unsigned char* stn = lds + (((n) + 1) & 1) * (16 * ST_LD * 2); \
            f32x4 acc0 = (f32x4){0.f, 0.f, 0.f, 0.f}, acc1 = acc0; \
            const bf16x8 sb0 = *(const LAS bf16x8*)(stc + (fr * ST_LD + 8 * fq) * 2), sb1 = *(const LAS bf16x8*)(stc + (fr * ST_LD + 32 + 8 * fq) * 2), \
                         sb2 = *(const LAS bf16x8*)(stc + (fr * ST_LD + 64 + 8 * fq) * 2), sb3 = *(const LAS bf16x8*)(stc + (fr * ST_LD + 96 + 8 * fq) * 2); \
            __builtin_amdgcn_sched_barrier(0); \
            acc0 = MF(pf[u][0], sb0, acc0); acc1 = MF(pf[u][1], sb1, acc1); acc0 = MF(pf[u][2], sb2, acc0); acc1 = MF(pf[u][3], sb3, acc1); \
            const float gl = __uint_as_float(__builtin_amdgcn_readlane(__float_as_uint((n) < 64 ? gla : glb2), (n) & 63)); \
            s[0] = gl * s[0] + bf_lo(nf[u].x) - (acc0[0] + acc1[0]); s[1] = gl * s[1] + bf_hi(nf[u].x) - (acc0[1] + acc1[1]); \
            s[2] = gl * s[2] + bf_lo(nf[u].y) - (acc0[2] + acc1[2]); s[3] = gl * s[3] + bf_hi(nf[u].y) - (acc0[3] + acc1[3]); \
            u32x2 w; w.x = cvt_pk_bf16(s[0], s[1]); w.y = cvt_pk_bf16(s[2], s[3]); \
            *(LAS u32x2*)(stn + (fr * ST_LD + 16 * wid + 4 * fq) * 2) = w; \
            if (!dry) *(u32x2*)(Nb + (size_t)(n) * 16384) = w; } while (0)
        SC_LOAD(0, 0); SC_LOAD(1, 1); SC_LOAD(2, 2); SC_LOAD(3, 3);
        for (int n4 = 0; n4 < 124; n4 += 4) {
            SC_STEP(0, n4, "s_waitcnt vmcnt(15)"); SC_LOAD(0, n4 + 4);
            SC_STEP(1, n4 + 1, "s_waitcnt vmcnt(15)"); SC_LOAD(1, n4 + 5);
            SC_STEP(2, n4 + 2, "s_waitcnt vmcnt(15)"); SC_LOAD(2, n4 + 6);
            SC_STEP(3, n4 + 3, "s_waitcnt vmcnt(15)"); SC_LOAD(3, n4 + 7);
        }
        SC_STEP(0, 124, "s_waitcnt vmcnt(0)"); SC_STEP(1, 125, "s_waitcnt vmcnt(0)"); SC_STEP(2, 126, "s_waitcnt vmcnt(0)"); SC_STEP(3, 127, "s_waitcnt vmcnt(0)");
#undef SC_STEP
#undef SC_LOAD
    }
}

__device__ __forceinline__ void phase_dn_out(const Params& p, int half, bool dry) {
    const int tid = otid(), wid = tid >> 6, lane = tid & 63, fr = lane & 15, fq = lane >> 4;
#ifdef DBG_PSRC
    bf16_t* QKV = (bf16_t*)(p.ws + OFF_QKV); const bf16_t* Ng = (const bf16_t*)(p.ws + OFF_P); const bf16_t* Z = (const bf16_t*)(p.ws + OFF_Z);
#else
    bf16_t* QKV = (bf16_t*)(p.ws + OFF_QKV); const bf16_t* Ng = (const bf16_t*)(p.ws + OFF_N); const bf16_t* Z = (const bf16_t*)(p.ws + OFF_Z);
#endif
    for (int it = obid(); it < 1024; it += ogdim()) {
        const int item = it * 2 + (wid >> 2), fi = wid & 3;
        const int n = item & 127, h = (item >> 7) & 7, bl = item >> 10, b = half * 2 + bl;
        const int t = b * SEQ + n * 64 + 16 * fi + fr;
        f32x4 acc[8];
#pragma unroll
        for (int f = 0; f < 8; ++f) acc[f] = (f32x4){0.f, 0.f, 0.f, 0.f};
        if (n > 0) {
            const bf16_t* St = Ng + (size_t)((bl * 8 + h) * 128 + n - 1) * 16384 + fr * 128 + 8 * fq;
            const bf16_t* Rp = QKV + (size_t)t * 3072 + h * 128 + 8 * fq;
#pragma unroll
            for (int ks = 0; ks < 4; ++ks) {
                const bf16x8 rf = *(const bf16x8*)(Rp + 32 * ks);
#pragma unroll
                #ifdef DBG_RONLY
                for (int f = 0; f < 8; ++f) acc[f] = MF(rf, rf, acc[f]);
#else
                for (int f = 0; f < 8; ++f) acc[f] = MF(*(const bf16x8*)(St + f * 16 * 128 + 32 * ks), rf, acc[f]);
#endif
            }
        }
        bf16_t* op = QKV + (size_t)t * 3072 + 1024 + h * 128 + 4 * fq;
        float ss = 0.f;
#pragma unroll
        for (int f = 0; f < 8; ++f) { const u32x2 o1 = *(const u32x2*)(op + 16 * f);
            acc[f][0] += bf_lo(o1.x); acc[f][1] += bf_hi(o1.x); acc[f][2] += bf_lo(o1.y); acc[f][3] += bf_hi(o1.y);
            ss += acc[f][0] * acc[f][0] + acc[f][1] * acc[f][1] + acc[f][2] * acc[f][2] + acc[f][3] * acc[f][3]; }
        ss += __shfl_xor(ss, 16); ss += __shfl_xor(ss, 32);
        const float rs = rsqrtf(ss * (1.0f / 128.0f) + 1e-6f);
        const bf16_t* zp = Z + (size_t)t * 1024 + h * 128 + 4 * fq;
#pragma unroll
        for (int f = 0; f < 8; ++f) {
            const u32x2 zv = *(const u32x2*)(zp + 16 * f); const f32x4 gn = *(const f32x4*)(p.dn_norm_g + 16 * f + 4 * fq);
            u32x2 w; w.x = cvt_pk_bf16(acc[f][0] * rs * gn[0] * silu_f(bf_lo(zv.x)), acc[f][1] * rs * gn[1] * silu_f(bf_hi(zv.x)));
            w.y = cvt_pk_bf16(acc[f][2] * rs * gn[2] * silu_f(bf_lo(zv.y)), acc[f][3] * rs * gn[3] * silu_f(bf_hi(zv.y)));
            if (!dry) *(u32x2*)(op + 16 * f) = w;
        }
    }
}

__device__ __forceinline__ void phase_sg_stats(const Params& p) {
    const int tid_ = otid(), wid = tid_ >> 6, lane = tid_ & 63;
    const bf16_t* V = (const bf16_t*)(p.ws + OFF_V); float* ST = (float*)(p.ws + OFF_STATS);
    for (int row = obid() * 8 + wid; row < T; row += ogdim() * 8) {
        float v[32]; float sum = 0.f;
#pragma unroll
        for (int i = 0; i < 4; ++i) { const u32x4 x = *(const u32x4*)(V + (size_t)row * 2048 + i * 512 + lane * 8);
            v[8 * i] = bf_lo(x.x); v[8 * i + 1] = bf_hi(x.x); v[8 * i + 2] = bf_lo(x.y); v[8 * i + 3] = bf_hi(x.y); v[8 * i + 4] = bf_lo(x.z); v[8 * i + 5] = bf_hi(x.z); v[8 * i + 6] = bf_lo(x.w); v[8 * i + 7] = bf_hi(x.w); }
#pragma unroll
        for (int i = 0; i < 32; ++i) sum += v[i];
#pragma unroll
        for (int o = 32; o >= 1; o >>= 1) sum += __shfl_xor(sum, o);
        const float mean = sum * (1.0f / 2048.0f); float q = 0.f;
#pragma unroll
        for (int i = 0; i < 32; ++i) { const float d = v[i] - mean; q += d * d; }
#pragma unroll
        for (int o = 32; o >= 1; o >>= 1) q += __shfl_xor(q, o);
        if (lane == 0) *(f32x2*)(ST + (size_t)row * 2) = (f32x2){mean, rsqrtf(q * (1.0f / 2048.0f) + 1e-5f)};
    }
}

constexpr int VT_LD = 136, UT_LD = 264, L_MX_ST = 256 * VT_LD * 2, L_MX_U = 71680, L_MX_W = L_MX_U + 128 * UT_LD * 2, L_MX_END = L_MX_W + 20 * 1024;
__host__ __device__ constexpr int mx_wbase(int tf) { return tf == 0 ? 0 : tf == 1 ? 1 : tf == 2 ? 2 : tf == 3 ? 4 : tf == 4 ? 6 : tf == 5 ? 9 : tf == 6 ? 12 : 16; }
__device__ __forceinline__ void phase_sg_mix(const Params& p, LAS unsigned char* lds, bool dry) {
    const int tid = otid(), wid = tid >> 6, lane = tid & 63, fr = lane & 15, fq = lane >> 4;
    const bf16_t* V = (const bf16_t*)(p.ws + OFF_V); bf16_t* U = (bf16_t*)(p.ws + OFF_U); const float* ST = (const float*)(p.ws + OFF_STATS);
    const bf16_t* Ws = (const bf16_t*)(p.ws + OFF_WS);
    LAS float* lst = (LAS float*)(lds + L_MX_ST);
    LAS unsigned char* ut = lds + L_MX_U;
    const int c = tid & 255, sh = tid >> 8;
    unsigned raw[64]; float stn = 0.f;
#define MX_LOAD(ITEM) do { const int it_ = (ITEM); if (it_ < 2048) { const int g_ = it_ & 7, t0_ = (it_ >> 3) * 128; \
        if (tid < 256) stn = ST[(size_t)t0_ * 2 + tid]; \
        _Pragma("unroll") for (int i = 0; i < 64; ++i) raw[i] = (unsigned)V[(size_t)(t0_ + 64 * sh + i) * 2048 + g_ * 256 + c]; } } while (0)
    int g_loaded = -1; float lg = 0.f, lb = 0.f;
    LAS float* lbs = (LAS float*)(lds + L_MX_END);
    MX_LOAD(obid());
    for (int item = obid(); item < 2048; item += ogdim()) {
        const int g = item & 7, cn = item >> 3, t0 = cn * 128;
        __syncthreads();
        if (g != g_loaded) {
            for (int q = tid; q < 20 * 64; q += NTHR) {
                const int pblk = q >> 6, row = (q & 63) >> 2, k8 = (q & 3) * 8;
                int tf = 0;
#pragma unroll
                for (int t = 1; t < 8; ++t) tf += (pblk >= mx_wbase(t)) ? 1 : 0;
                const int ks = pblk - mx_wbase(tf);
                *(LAS u32x4*)(lds + L_MX_W + pblk * 1024 + (row * 32 + k8) * 2) = *(const u32x4*)(Ws + (size_t)g * 16384 + (16 * tf + row) * 128 + 32 * ks + k8);
            }
            lg = p.sg_ln_g[g * 256 + c]; lb = p.sg_ln_b[g * 256 + c];
            if (tid < 128) lbs[tid] = p.sg_b_s[g * 128 + tid];
            g_loaded = g;
        }
        if (tid < 256) lst[tid] = stn;
#pragma unroll
        for (int k = 0; k < 8; ++k) { const int pid = otid() + 512 * k, row = pid >> 5, c16 = pid & 31;
            *(LAS u32x4*)(ut + (row * UT_LD + c16 * 8) * 2) = *(const u32x4*)(U + (size_t)(t0 + row) * 2048 + g * 256 + c16 * 8); }
        __syncthreads();
#pragma unroll
        for (int sg = 0; sg < 8; ++sg) {
            const int s0 = 64 * sh + 8 * sg; float v[8];
#pragma unroll
            for (int i = 0; i < 8; ++i) v[i] = (__uint_as_float(raw[8 * sg + i] << 16) - lst[2 * (s0 + i)]) * lst[2 * (s0 + i) + 1] * lg + lb;
            u32x4 w; w.x = cvt_pk_bf16(v[0], v[1]); w.y = cvt_pk_bf16(v[2], v[3]); w.z = cvt_pk_bf16(v[4], v[5]); w.w = cvt_pk_bf16(v[6], v[7]);
            *(LAS u32x4*)(lds + (c * VT_LD + s0) * 2) = w;
        }
        MX_LOAD(item + ogdim());
        __syncthreads();
        f32x4 acc[8][2];
#pragma unroll
        for (int tf = 0; tf < 8; ++tf) { acc[tf][0] = (f32x4){0.f, 0.f, 0.f, 0.f}; acc[tf][1] = acc[tf][0]; }
#pragma unroll
        for (int ks = 0; ks < 4; ++ks) {
            const bf16x8 v0 = lds_frag(lds, VT_LD, 32 * wid, 32 * ks, fr, fq), v1 = lds_frag(lds, VT_LD, 32 * wid + 16, 32 * ks, fr, fq);
#pragma unroll
            for (int tf = 0; tf < 8; ++tf) {
                if (32 * ks <= 16 * tf + 15) {
                    const bf16x8 wf = *(const LAS bf16x8*)(lds + L_MX_W + (mx_wbase(tf) + ks) * 1024 + (fr * 32 + 8 * fq) * 2);
                    acc[tf][0] = MF(v0, wf, acc[tf][0]); acc[tf][1] = MF(v1, wf, acc[tf][1]);
                }
            }
        }
#pragma unroll
        for (int tf = 0; tf < 8; ++tf) {
            const int t = 16 * tf + fr; const float bs = lbs[t];
#pragma unroll
            for (int cf = 0; cf < 2; ++cf) {
                LAS unsigned char* up = ut + (t * UT_LD + 32 * wid + 16 * cf + 4 * fq) * 2;
                const u32x2 uv = *(const LAS u32x2*)up;
                u32x2 w; w.x = cvt_pk_bf16(bf_lo(uv.x) * (acc[tf][cf][0] + bs), bf_hi(uv.x) * (acc[tf][cf][1] + bs));
                w.y = cvt_pk_bf16(bf_lo(uv.y) * (acc[tf][cf][2] + bs), bf_hi(uv.y) * (acc[tf][cf][3] + bs));
                *(LAS u32x2*)up = w;
            }
        }
        __syncthreads();
        if (!dry) {
#pragma unroll
            for (int k = 0; k < 8; ++k) { const int pid = otid() + 512 * k, row = pid >> 5, c16 = pid & 31;
                *(u32x4*)(U + (size_t)(t0 + row) * 2048 + g * 256 + c16 * 8) = *(const LAS u32x4*)(ut + (row * UT_LD + c16 * 8) * 2); }
        }
    }
}


#undef MX_LOAD
#define XB_TMO      128
#define XB_XCNT(j)  (256  + 64 * (j))
#define XB_XSUB(j)  (1280 + 64 * (j))
#define XB_XGEN(j)  (2304 + 64 * (j))
#define XB_TOP      3328
#define XB_TOPGEN   3392
#define XB_SPIN_CAP (1u << 18)
__device__ __forceinline__ unsigned xb_ld(unsigned* p)              { return __hip_atomic_load(p, __ATOMIC_RELAXED, __HIP_MEMORY_SCOPE_AGENT); }
__device__ __forceinline__ unsigned xb_add(unsigned* p, unsigned v) { return __hip_atomic_fetch_add(p, v, __ATOMIC_RELAXED, __HIP_MEMORY_SCOPE_AGENT); }
__device__ __forceinline__ unsigned xb_xcc_id() { return (unsigned)__builtin_amdgcn_s_getreg((3 << 11) | 20) & 0xFu; }
#define XB_SPIN(cond, bar) do { unsigned _sp = 0; while (cond) { __builtin_amdgcn_s_sleep(1); \
    if ((++_sp & 255u) == 0u) { if (xb_ld(&(bar)[XB_TMO])) break; if (_sp > XB_SPIN_CAP) { atomicAdd(&(bar)[XB_TMO], 1u); break; } } } } while (0)
struct XcdBarrier { unsigned* bar; unsigned x; volatile LAS unsigned* st; };
__device__ __forceinline__ XcdBarrier xcd_barrier_post(unsigned* bar, volatile LAS unsigned* st) {
    XcdBarrier b; b.bar = bar; b.x = xb_xcc_id(); b.st = st;
    if (threadIdx.x == 0) (void)xb_add(&bar[XB_XCNT(b.x)], 1u);
    return b;
}
__device__ __forceinline__ void xcd_barrier_complete(unsigned* bar, unsigned x, unsigned& nloc, unsigned& nx) {
    const unsigned G = gridDim.x * gridDim.y * gridDim.z;
    unsigned sum, cnt, mine, sp = 0u;
    for (;;) {
        sum = 0u; cnt = 0u; mine = 0u;
#pragma unroll
        for (unsigned j = 0; j < 16; ++j) { const unsigned c = xb_ld(&bar[XB_XCNT(j)]); sum += c; cnt += (c > 0u) ? 1u : 0u; mine = (j == x) ? c : mine; }
        if (sum == G) break;
        __builtin_amdgcn_s_sleep(1);
        if ((++sp & 255u) == 0u) { if (xb_ld(&bar[XB_TMO])) break; if (sp > XB_SPIN_CAP) { atomicAdd(&bar[XB_TMO], 1u); break; } }
    }
    nloc = mine > 0u ? mine : 1u; nx = cnt > 0u ? cnt : 1u;
}
__device__ __forceinline__ void xcd_barrier(const XcdBarrier& b) {
    asm volatile("s_waitcnt vmcnt(0)" ::: "memory");
    __syncthreads();
    if (threadIdx.x == 0) {
        unsigned* bar = b.bar;
        __builtin_amdgcn_s_waitcnt(0);
        unsigned nloc = b.st[0], nx = b.st[1];
        if (nloc == 0u) { xcd_barrier_complete(bar, b.x, nloc, nx); b.st[0] = nloc; b.st[1] = nx; }
        const unsigned old = xb_add(&bar[XB_XSUB(b.x)], 1u);
        const unsigned gen = old / nloc;
        if (old + 1u == (gen + 1u) * nloc) {
            __builtin_amdgcn_fence(__ATOMIC_RELEASE, "agent");
            asm volatile("s_waitcnt vmcnt(0)" ::: "memory");
            const unsigned og = xb_add(&bar[XB_TOP], 1u);
            const unsigned tg = og / nx;
            if (og + 1u == (tg + 1u) * nx) xb_add(&bar[XB_TOPGEN], 1u);
            else XB_SPIN(xb_ld(&bar[XB_TOPGEN]) == tg, bar);
            __builtin_amdgcn_fence(__ATOMIC_ACQUIRE, "agent");
            xb_add(&bar[XB_XGEN(b.x)], 1u);
            asm volatile("s_waitcnt vmcnt(0)" ::: "memory");
        } else {
            XB_SPIN(xb_ld(&bar[XB_XGEN(b.x)]) == gen, bar);
            __builtin_amdgcn_fence(__ATOMIC_ACQUIRE, "agent");
            asm volatile("s_waitcnt vmcnt(0)" ::: "memory");
        }
    }
    __syncthreads();
}

constexpr int NPH = 27;
__device__ __forceinline__ bool probe_rep(int ph) {
#if PROBE_REP == 1
    return ph == 1 || ph == 2 || ph == 4 || ph == 11 || ph == 13 || ph == 14 || ph == 16 || ph == 17 || ph == 19 || ph == 22 || ph == 24 || ph == 25;
#elif PROBE_REP == 2
    return ph == 0 || ph == 3 || ph == 12 || ph == 15 || ph == 18 || ph == 23 || ph == 26 || ph == 20;
#elif PROBE_REP == 3
    return ph == 5 || ph == 8 || ph == 7 || ph == 10 || ph == 21;
#elif PROBE_REP == 4
    return ph == 6 || ph == 9;
#elif PROBE_REP == 5
    return ph == 1 || ph == 13 || ph == 16 || ph == 24;
#elif PROBE_REP == 7
    return ph == 5 || ph == 8;
#elif PROBE_REP == 8
    return ph == 21;
#elif PROBE_REP == 6
    return ph == 2 || ph == 14 || ph == 17 || ph == 25;
#else
    return false;
#endif
}
__device__ __forceinline__ void run_phase(const Params& p, int ph_, LAS unsigned char* lds) {
    const int ph = ph_ & 0xff; const float rcoef = (ph_ & 0x100) ? 0.0f : 1.0f;
    unsigned char* ws = p.ws;
    bf16_t* H = (bf16_t*)(ws + OFF_H); bf16_t* Y = (bf16_t*)(ws + OFF_Y); bf16_t* ACT = (bf16_t*)(ws + OFF_ACT);
    const float* ng = p.norm_g;
    int ffn = -1, sub = 0;
    if (ph >= 1 && ph <= 3) { ffn = 0; sub = ph - 1; }
    else if (ph >= 13 && ph <= 15) { ffn = 1; sub = ph - 13; }
    else if (ph >= 16 && ph <= 18) { ffn = 2; sub = ph - 16; }
    else if (ph >= 24 && ph <= 26) { ffn = 3; sub = ph - 24; }
    if (ffn >= 0) {
        if (sub == 0) { EpiSwiGLU e; e.O = ACT; run_gemm(lds, H, DM, (const bf16_t*)(ws + OFF_WGU + ffn * SZ_WGU), T, 2 * FF, DM, e); }
        else if (sub == 1) { EpiBf16Y e; e.O = Y; run_gemm(lds, ACT, FF, (const bf16_t*)(ws + OFF_WD + ffn * SZ_WD), T, DM, FF, e); }
        else {
            const int layer = ffn >> 1, second = ffn & 1;
            const float* gpost = ng + (layer * 6 + (second ? 5 : 1)) * DM;
            const float* gpre = second ? (layer == 0 ? ng + (1 * 6 + 0) * DM : nullptr) : ng + (layer * 6 + 2) * DM;
            phase_rowwise(ffn == 0 ? p.x : (const float*)p.out, p.out, Y, gpost, (ffn == 0 ? 0.5f : 0.5f * rcoef), gpre, H);
        }
        return;
    }
    switch (ph) {
    case 0: prep_weights(p, lds, 0, PREP_EARLY, obid(), ogdim()); phase_rowwise(p.x, nullptr, nullptr, nullptr, 0.f, ng, H); break;
    case 4: { EpiDnIn e; e.QKV = (bf16_t*)(ws + OFF_QKV); e.Z = (bf16_t*)(ws + OFF_Z); e.BA = (float*)(ws + OFF_BA); e.HALO = (bf16_t*)(ws + OFF_HALO);
        run_gemm(lds, H, DM, (const bf16_t*)(ws + OFF_WDNIN), T, 4352, DM, e); } break;
    case 5: case 8: phase_dn_local(p, ph == 8 ? 1 : 0, lds, rcoef == 0.0f); break;
    case 6: case 9: phase_dn_scan(p, ph == 9 ? 1 : 0, lds, rcoef == 0.0f); break;
    case 7: case 10: phase_dn_out(p, ph == 10 ? 1 : 0, rcoef == 0.0f); break;
    case 11: { EpiBf16Y e; e.O = Y; run_gemm(lds, (const bf16_t*)(ws + OFF_QKV) + 1024, 3072, (const bf16_t*)(ws + OFF_WDNOUT), T, DM, DM, e); } break;
    case 12: phase_rowwise(p.out, p.out, Y, ng + 3 * DM, rcoef, ng + 4 * DM, H); break;
    case 19: { EpiSgIn e; e.U = (bf16_t*)(ws + OFF_U); e.V = (bf16_t*)(ws + OFF_V); e.bias = p.sg_b_in;
        run_gemm(lds, H, DM, (const bf16_t*)(ws + OFF_WSGIN), T, 4096, DM, e); } break;
    case 20: phase_sg_stats(p); break;
    case 21: phase_sg_mix(p, lds, rcoef == 0.0f); break;
    case 22: { EpiBf16Y e; e.O = Y; run_gemm(lds, (const bf16_t*)(ws + OFF_U), 2048, (const bf16_t*)(ws + OFF_WSGOUT), T, DM, 2048, e); } break;
    case 23: phase_rowwise(p.out, p.out, Y, ng + (6 + 3) * DM, rcoef, ng + (6 + 4) * DM, H); break;
    default: break;
    }
}

constexpr int LDS_BYTES = 157 * 1024;
static_assert(L_D1END <= LDS_BYTES && pg8::STAGE_BYTES <= LDS_BYTES && L_MX_END + 512 <= LDS_BYTES - 16 && L_MX_ST + 1024 <= L_MX_U, "LDS budget");

__global__ __launch_bounds__(512, 2) void mega(Params p, int ph_lo, int ph_hi) {
    extern __shared__ __attribute__((aligned(16))) unsigned char shm[];
    LAS unsigned char* lds = (LAS unsigned char*)shm;
#ifdef TEST_PH
    run_phase(p, TEST_PH, lds);
#else
#if MK_ONE_LAUNCH
    volatile LAS unsigned* xbst = (volatile LAS unsigned*)(lds + LDS_BYTES - 16);
    if (threadIdx.x == 0) { xbst[0] = 0u; xbst[1] = 0u; }
    __syncthreads();
    const XcdBarrier xb = xcd_barrier_post((unsigned*)(p.ws + OFF_BAR), xbst);
#endif
    for (int ph = ph_lo; ph < ph_hi; ++ph) {
#if MK_ONE_LAUNCH
        if (ph > ph_lo) { if (ph_hi > 4096) cg::this_grid().sync(); else xcd_barrier(xb); }
#else
        if (ph > ph_lo) cg::this_grid().sync();
#endif
#ifdef PROBE_REP
        if (probe_rep(ph)) {
            Params q0 = p;
            asm volatile("" : "+s"(q0.ws), "+s"(q0.out), "+s"(q0.norm_g), "+s"(q0.x));
            run_phase(q0, ph | 0x100, lds);
            cg::this_grid().sync();
        }
#endif
        Params q = p;
        asm volatile("" : "+s"(q.ws), "+s"(q.out), "+s"(q.norm_g), "+s"(q.x));
        asm volatile("" : "+s"(q.dn_conv_w), "+s"(q.dn_a_log), "+s"(q.dn_dt_bias), "+s"(q.dn_norm_g));
        asm volatile("" : "+s"(q.sg_b_in), "+s"(q.sg_ln_g), "+s"(q.sg_ln_b), "+s"(q.sg_b_s));
        run_phase(q, ph, lds);
    }
#endif
}

extern "C" void kernel_launch(void* const* d_in, const int* in_sizes, int n_in, void* d_out, int out_size, void* d_ws, size_t ws_size, hipStream_t stream) {
    static int grid = 0;
    if (grid == 0) {
        if (n_in != 18 || in_sizes[0] != T * DM || out_size != T * DM || ws_size < WS_END) { fprintf(stderr, "kernel_launch: unexpected shapes (n_in %d, ws %zu, need %zu)\n", n_in, ws_size, (size_t)WS_END); grid = -1; return; }
        if (hipFuncSetAttribute((const void*)mega, hipFuncAttributeMaxDynamicSharedMemorySize, LDS_BYTES) != hipSuccess) { fprintf(stderr, "kernel_launch: hipFuncSetAttribute failed\n"); grid = -1; return; }
        int dev = 0, cus = 0, per_cu = 0;
        hipGetDevice(&dev); hipDeviceGetAttribute(&cus, hipDeviceAttributeMultiprocessorCount, dev);
        hipOccupancyMaxActiveBlocksPerMultiprocessor(&per_cu, (const void*)mega, NTHR, LDS_BYTES);
        if (per_cu < 1) { fprintf(stderr, "kernel_launch: occupancy query says 0 blocks per CU\n"); grid = -1; return; }
        grid = cus;
    }
    if (grid < 0) return;
    Params p{};
    p.x = (const float*)d_in[0]; p.norm_g = (const float*)d_in[1]; p.w_gate = (const float*)d_in[2]; p.w_up = (const float*)d_in[3]; p.w_down = (const float*)d_in[4];
    p.dn_w_in = (const float*)d_in[5]; p.dn_conv_w = (const float*)d_in[6]; p.dn_a_log = (const float*)d_in[7]; p.dn_dt_bias = (const float*)d_in[8]; p.dn_norm_g = (const float*)d_in[9];
    p.dn_w_out = (const float*)d_in[10]; p.sg_w_in = (const float*)d_in[11]; p.sg_b_in = (const float*)d_in[12]; p.sg_ln_g = (const float*)d_in[13]; p.sg_ln_b = (const float*)d_in[14];
    p.sg_w_s = (const float*)d_in[15]; p.sg_b_s = (const float*)d_in[16]; p.sg_w_out = (const float*)d_in[17];
    p.out = (float*)d_out; p.ws = (unsigned char*)d_ws;
#if MK_ONE_LAUNCH
    if (hipMemsetAsync((unsigned char*)d_ws + OFF_BAR, 0, (size_t)XCD_BAR_WORDS * 4, stream) != hipSuccess) { fprintf(stderr, "kernel_launch: hipMemsetAsync of the barrier words failed\n"); return; }
    int lo = 0, hi = NPH;
    void* args[] = {&p, &lo, &hi};
    hipError_t e = hipLaunchCooperativeKernel((const void*)mega, dim3(grid), dim3(NTHR), args, LDS_BYTES, stream);
    if (e != hipSuccess) fprintf(stderr, "cooperative launch failed: %s (grid %d)\n", hipGetErrorString(e), grid);
#else
    for (int ph = 0; ph < NPH; ++ph) {
#ifdef SKIP_DN
        if (ph >= 4 && ph <= 12) continue;
#endif
#ifdef DBG_NOSCAN
        if (ph == 6 || ph == 9) continue;
        if (ph >= 8 && ph <= 10) continue;
#endif
#ifdef SKIP_SG
        if (ph >= 19 && ph <= 23) continue;
#endif
        hipLaunchKernelGGL(mega, dim3(grid), dim3(NTHR), LDS_BYTES, stream, p, ph, ph + 1);
    }
#endif
}
```

```cpp
#include <hip/hip_runtime.h>
#include <hip/hip_cooperative_groups.h>
#include <cstdio>
namespace cg = cooperative_groups;

#ifndef MK_ONE_LAUNCH
#define MK_ONE_LAUNCH 1
#endif

#define LAS __attribute__((address_space(3)))
typedef unsigned short bf16_t;
typedef short bf16x8 __attribute__((ext_vector_type(8)));
typedef float f32x4 __attribute__((ext_vector_type(4)));
typedef float f32x2 __attribute__((ext_vector_type(2)));
typedef unsigned u32x4 __attribute__((ext_vector_type(4)));
typedef unsigned u32x2 __attribute__((ext_vector_type(2)));

constexpr int T = 32768, DM = 1024, FF = 2816, SEQ = 8192;
constexpr int NTHR = 512;
constexpr size_t MiB = 1048576;
constexpr size_t SZ_WGU = (size_t)5632 * 1024 * 2, SZ_WD = (size_t)1024 * 2816 * 2;
constexpr size_t OFF_WGU = 0;
constexpr size_t OFF_WD = OFF_WGU + 4 * SZ_WGU;
constexpr size_t OFF_WDNIN = OFF_WD + 4 * SZ_WD;
constexpr size_t OFF_WDNOUT = OFF_WDNIN + (size_t)4352 * 1024 * 2;
constexpr size_t OFF_WSGIN = OFF_WDNOUT + (size_t)1024 * 1024 * 2;
constexpr size_t OFF_WSGOUT = OFF_WSGIN + (size_t)4096 * 1024 * 2;
constexpr size_t OFF_WS = OFF_WSGOUT + (size_t)1024 * 2048 * 2;
constexpr size_t OFF_GL = OFF_WS + (size_t)8 * 128 * 128 * 2;
constexpr size_t OFF_STATS = OFF_GL + (size_t)4096 * 4;
constexpr size_t OFF_BAR = OFF_STATS + (size_t)T * 8;
constexpr int XCD_BAR_WORDS = 3456 + 16 * 64;
constexpr int LDS_WGID_OFF = 157 * 1024 - 8;
constexpr size_t AR = 94 * MiB;
static_assert(OFF_BAR + (size_t)XCD_BAR_WORDS * 4 <= AR, "weights region overflow");
constexpr size_t OFF_H = AR, OFF_Y = AR + 64 * MiB, OFF_ACT = AR + 192 * MiB;
constexpr size_t OFF_QKV = AR + 226 * MiB, OFF_P = AR, OFF_Z = AR + 64 * MiB, OFF_BA = AR + 128 * MiB, OFF_HALO = AR + 130 * MiB, OFF_N = AR + 139 * MiB;
constexpr size_t OFF_U = AR + 192 * MiB, OFF_V = AR + 64 * MiB;
constexpr size_t WS_END = AR + 418 * MiB;

struct Params {
    const float* x; const float* norm_g; const float* w_gate; const float* w_up; const float* w_down;
    const float* dn_w_in; const float* dn_conv_w; const float* dn_a_log; const float* dn_dt_bias; const float* dn_norm_g; const float* dn_w_out;
    const float* sg_w_in; const float* sg_b_in; const float* sg_ln_g; const float* sg_ln_b; const float* sg_w_s; const float* sg_b_s; const float* sg_w_out;
    float* out; unsigned char* ws;
};

typedef __bf16 bf16x2_t __attribute__((ext_vector_type(2)));
__device__ __forceinline__ unsigned cvt_pk_bf16(float lo, float hi) { f32x2 v = {lo, hi}; bf16x2_t r = __builtin_convertvector(v, bf16x2_t); return __builtin_bit_cast(unsigned, r); }
__device__ __forceinline__ float bf_lo(unsigned u) { return __uint_as_float(u << 16); }
__device__ __forceinline__ float bf_hi(unsigned u) { return __uint_as_float(u & 0xffff0000u); }
__device__ __forceinline__ float bf2f(bf16_t b) { return __uint_as_float(((unsigned)b) << 16); }
__device__ __forceinline__ float silu_f(float v) { return v * __builtin_amdgcn_rcpf(1.0f + __expf(-v)); }
__device__ __forceinline__ float gelu_f(float v) {
    const float av = fabsf(v), t = __builtin_amdgcn_rcpf(av * 0.2316418882f + 1.0f);
    float q = t * 0.5307027145f + (-0.7265760135f); q = q * t + 0.7107068705f; q = q * t + (-0.142248368f); q = q * t + 0.127414796f; q = q * t;
    const float e = __builtin_amdgcn_exp2f((v * v) * (-0.72134752044f));
    const float m = v * (q * e);
    return v < 0.f ? m : v - m;
}
__device__ __forceinline__ f32x2 gelu_pk(f32x2 v) {
    const f32x2 av = __builtin_elementwise_abs(v), d = av * 0.2316418882f + 1.0f;
    f32x2 t; t.x = __builtin_amdgcn_rcpf(d.x); t.y = __builtin_amdgcn_rcpf(d.y);
    f32x2 q = t * 0.5307027145f + (-0.7265760135f); q = q * t + 0.7107068705f; q = q * t + (-0.142248368f); q = q * t + 0.127414796f; q = q * t;
    const f32x2 sq = (v * v) * (-0.72134752044f);
    f32x2 e; e.x = __builtin_amdgcn_exp2f(sq.x); e.y = __builtin_amdgcn_exp2f(sq.y);
    const f32x2 m = v * (q * e), r = v - m;
    f32x2 o; o.x = v.x < 0.f ? m.x : r.x; o.y = v.y < 0.f ? m.y : r.y; return o;
}
__host__ __device__ __forceinline__ int perm32(int rho) { const int n = rho >> 4, i = rho & 15; return 8 * (i >> 2) + 4 * n + (i & 3); }
__device__ __forceinline__ int otid() { int t = threadIdx.x; asm volatile("" : "+v"(t)); return t; }
__device__ __forceinline__ int obid() { int t = (int)blockIdx.x; asm volatile("" : "+s"(t)); return t; }
__device__ __forceinline__ int ogdim() { int t = (int)gridDim.x; asm volatile("" : "+s"(t)); return t; }
#define MF(x, y, acc) __builtin_amdgcn_mfma_f32_16x16x32_bf16((x), (y), (acc), 0, 0, 0)

namespace pg8 {
constexpr int BM = 256, BK = 64, HALF = 128, HTB = HALF * BK * 2, STAGE_BYTES = 8 * HTB, NXCD = 8, WGM = 8;
__host__ __device__ __forceinline__ int lds_byte(int r, int c) { const int st = (r >> 4) * 2 + (c >> 5), rr = r & 15, cc = c & 31, ob = rr * 64 + cc * 2; return st * 1024 + (ob ^ (((ob >> 9) & 1) << 5)); }
__host__ __device__ __forceinline__ void stage_rc(int b, int& R, int& C) { const int st = b / 1024, sb = b % 1024, swz = sb ^ (((sb >> 9) & 1) << 5); R = (st >> 1) * 16 + swz / 64; C = (st & 1) * 32 + (swz % 64) / 2; }
struct Unit { int pm, pn; };
struct Gemm { const bf16_t* A; const bf16_t* Bt; int M, N, K, lda; };
struct StaticOrder {
    int nM, nN, nwg, G, c;
    __host__ __device__ void init(int M, int N, int G_, int c_) { nM = M / BM; nN = N / BM; nwg = nM * nN; G = G_; c = c_; }
    __host__ __device__ bool next(int i, Unit& u) const {
        const long L = (long)i * G + c; if (L >= nwg) return false;
        int wgid = (int)L; { const int q = nwg / NXCD, r = nwg % NXCD, xcd = wgid % NXCD, off = wgid / NXCD; wgid = (xcd < r ? xcd * (q + 1) : r * (q + 1) + (xcd - r) * q) + off; }
        const int nig = WGM * nN, gid = wgid / nig, fm = gid * WGM, gsz = (nM - fm) < WGM ? (nM - fm) : WGM;
        u.pm = fm + ((wgid % nig) % gsz); u.pn = (wgid % nig) / gsz; return true;
    }
};

template <class Epi>
__device__ __forceinline__ void gemm_phase(LAS unsigned char* lds, const Gemm g, const StaticOrder& S, const Epi& E) {
    const int tid = otid(), wid = __builtin_amdgcn_readfirstlane(tid >> 6), lane = tid & 63, wr = wid >> 2, wc = wid & 3, fr = lane & 15, fq = lane >> 4;
    const int K = g.K, nt = K / BK, lda = g.lda;
    unsigned voffA[2], voffB[2];
#pragma unroll
    for (int i = 0; i < 2; ++i) { int R, C; stage_rc(tid * 16 + i * 8192, R, C);
        voffA[i] = (unsigned)(R * lda + C) * 2u; voffB[i] = (unsigned)(R * K + C) * 2u; }
    const size_t kstep = (size_t)(BK * 2);
    const size_t hstepA = (size_t)HALF * lda * 2, hstepB = (size_t)HALF * K * 2;
    const size_t tstepA = 2 * hstepA, tstepB = 2 * hstepB;
    const unsigned ldsw = (unsigned)wid * 1024u;
    const int aoff = lds_byte(wr * 64 + fr, fq * 8), boff = lds_byte(wc * 32 + fr, fq * 8);
#define PG8_SA(b, h) (((b) * 2 + (h)) * HTB)
#define PG8_SB(b, h) ((4 + (b) * 2 + (h)) * HTB)
#define PG8_STAGE(bufoff, gbase, voff) do { _Pragma("unroll") for (int _i = 0; _i < 2; ++_i) \
        __builtin_amdgcn_global_load_lds((const unsigned*)((const char*)(gbase) + (voff)[_i]), (LAS unsigned*)(lds + (bufoff) + ldsw + _i * 8192), 16, 0, 0); } while (0)
#define PG8_LDA(dst, b, h) do { _Pragma("unroll") for (int m = 0; m < 4; ++m) _Pragma("unroll") for (int k = 0; k < 2; ++k) dst[m][k] = *(const LAS bf16x8*)(lds + PG8_SA(b, h) + aoff + m * 2048 + k * 1024); } while (0)
#define PG8_LDB(dst, b, h) do { _Pragma("unroll") for (int n = 0; n < 2; ++n) _Pragma("unroll") for (int k = 0; k < 2; ++k) dst[n][k] = *(const LAS bf16x8*)(lds + PG8_SB(b, h) + boff + n * 2048 + k * 1024); } while (0)
#define PG8_MMA(ai, bj, At, Bt) do { __builtin_amdgcn_s_setprio(1); _Pragma("unroll") for (int m = 0; m < 4; ++m) _Pragma("unroll") for (int n = 0; n < 2; ++n) _Pragma("unroll") for (int k = 0; k < 2; ++k) \
        acc[ai][bj][m][n] = __builtin_amdgcn_mfma_f32_16x16x32_bf16(Bt[n][k], At[m][k], acc[ai][bj][m][n], 0, 0, 0); __builtin_amdgcn_s_setprio(0); } while (0)
#define PG8_WAIT_V(n) asm volatile("s_waitcnt vmcnt(" #n ")" ::: "memory")
#define PG8_WAIT_L(n) asm volatile("s_waitcnt lgkmcnt(" #n ")" ::: "memory")
#define PG8_BAR __builtin_amdgcn_s_barrier()
#define PG8_SCHED __builtin_amdgcn_sched_barrier(0)
    Unit cur, nxt; int ui = 0;
    if (!S.next(0, cur)) return;
    f32x4 acc[2][2][4][2];
#pragma unroll
    for (int a = 0; a < 2; ++a)
#pragma unroll
        for (int b = 0; b < 2; ++b)
#pragma unroll
            for (int m = 0; m < 4; ++m)
#pragma unroll
                for (int n = 0; n < 2; ++n) acc[a][b][m][n] = (f32x4){0.f, 0.f, 0.f, 0.f};
    bf16x8 At[4][2], B0[2][2], B1[2][2];
    const char* cA = (const char*)g.A + (size_t)cur.pm * tstepA; const char* cB = (const char*)g.Bt + (size_t)cur.pn * tstepB;
    PG8_STAGE(PG8_SB(0, 0), cB, voffB); PG8_STAGE(PG8_SA(0, 0), cA, voffA); PG8_STAGE(PG8_SB(0, 1), cB + hstepB, voffB); PG8_STAGE(PG8_SA(0, 1), cA + hstepA, voffA);
    if (wr == 1) PG8_BAR;
    PG8_WAIT_V(4); PG8_BAR;
    PG8_STAGE(PG8_SB(1, 0), cB + kstep, voffB); PG8_STAGE(PG8_SA(1, 0), cA + kstep, voffA); PG8_STAGE(PG8_SB(1, 1), cB + hstepB + kstep, voffB);
    PG8_WAIT_V(6); PG8_BAR;
    for (;;) {
        const bool has_next = S.next(ui + 1, nxt);
        const char* nA = has_next ? (const char*)g.A + (size_t)nxt.pm * tstepA : cA; const char* nB = has_next ? (const char*)g.Bt + (size_t)nxt.pn * tstepB : cB;
        for (int t = 0; t < nt; t += 2) {
            const bool last = (t == nt - 2);
            const char* a1 = cA + (size_t)(t + 1) * kstep;
            const char* a2 = last ? nA : cA + (size_t)(t + 2) * kstep; const char* b2 = last ? nB : cB + (size_t)(t + 2) * kstep;
            const char* a3 = a2 + kstep; const char* b3 = b2 + kstep;
            PG8_LDB(B0, 0, 0); PG8_SCHED; PG8_LDA(At, 0, 0); PG8_STAGE(PG8_SA(1, 1), a1 + hstepA, voffA);
            PG8_WAIT_L(8); PG8_BAR; PG8_WAIT_L(0); PG8_MMA(0, 0, At, B0); PG8_BAR; PG8_SCHED;
            PG8_LDB(B1, 0, 1); PG8_STAGE(PG8_SB(0, 0), b2, voffB);
            PG8_BAR; PG8_WAIT_L(0); PG8_MMA(0, 1, At, B1); PG8_BAR;
            PG8_LDA(At, 0, 1); PG8_STAGE(PG8_SA(0, 0), a2, voffA);
            PG8_BAR; PG8_WAIT_L(0); PG8_MMA(1, 0, At, B0); PG8_BAR; PG8_SCHED;
            PG8_STAGE(PG8_SB(0, 1), b2 + hstepB, voffB);
            PG8_WAIT_V(6); PG8_BAR; PG8_MMA(1, 1, At, B1); PG8_BAR;
            PG8_LDB(B0, 1, 0); PG8_SCHED; PG8_LDA(At, 1, 0); PG8_STAGE(PG8_SA(0, 1), a2 + hstepA, voffA);
            PG8_WAIT_L(8); PG8_BAR; PG8_WAIT_L(0); PG8_MMA(0, 0, At, B0); PG8_BAR; PG8_SCHED;
            PG8_LDB(B1, 1, 1); PG8_STAGE(PG8_SB(1, 0), b3, voffB);
            PG8_BAR; PG8_WAIT_L(0); PG8_MMA(0, 1, At, B1); PG8_BAR;
            PG8_LDA(At, 1, 1); PG8_STAGE(PG8_SA(1, 0), a3, voffA);
            PG8_BAR; PG8_WAIT_L(0); PG8_MMA(1, 0, At, B0); PG8_BAR; PG8_SCHED;
            PG8_STAGE(PG8_SB(1, 1), b3 + hstepB, voffB);
            PG8_WAIT_V(6); PG8_BAR; PG8_MMA(1, 1, At, B1); PG8_BAR;
        }
        E(acc, cur, wr, wc, fr, fq);
        if (!has_next) break;
#pragma unroll
        for (int a = 0; a < 2; ++a)
#pragma unroll
            for (int b = 0; b < 2; ++b)
#pragma unroll
                for (int m = 0; m < 4; ++m)
#pragma unroll
                    for (int n = 0; n < 2; ++n) acc[a][b][m][n] = (f32x4){0.f, 0.f, 0.f, 0.f};
        cur = nxt; cA = nA; cB = nB; ++ui;
    }
    PG8_WAIT_V(0);
    if (wr == 0) PG8_BAR;
    PG8_BAR;
#undef PG8_SA
#undef PG8_SB
#undef PG8_STAGE
#undef PG8_LDA
#undef PG8_LDB
#undef PG8_MMA
#undef PG8_WAIT_V
#undef PG8_WAIT_L
#undef PG8_BAR
#undef PG8_SCHED
}
}

struct EpiF32 {
    float* C; int ldc;
    __device__ __forceinline__ void operator()(const f32x4 (&acc)[2][2][4][2], const pg8::Unit& u, int wr, int wc, int fr, int fq) const {
        const int row0 = u.pm * 256 + wr * 64 + fr, col0 = u.pn * 256 + wc * 32 + 4 * fq;
#pragma unroll
        for (int ai = 0; ai < 2; ++ai)
#pragma unroll
            for (int m = 0; m < 4; ++m) { float* rowp = C + (size_t)(row0 + ai * 128 + m * 16) * ldc + col0;
#pragma unroll
                for (int bj = 0; bj < 2; ++bj)
#pragma unroll
                    for (int n = 0; n < 2; ++n) *(f32x4*)(rowp + bj * 128 + n * 16) = acc[ai][bj][m][n]; }
    }
};
struct EpiBf16Y {
    bf16_t* O;
    __device__ __forceinline__ void operator()(const f32x4 (&acc)[2][2][4][2], const pg8::Unit& u, int wr, int wc, int fr, int fq) const {
        const int row0 = u.pm * 256 + wr * 64 + fr, col0 = u.pn * 256 + wc * 32 + 8 * fq;
#pragma unroll
        for (int ai = 0; ai < 2; ++ai)
#pragma unroll
            for (int m = 0; m < 4; ++m) { bf16_t* rowp = O + (size_t)(row0 + ai * 128 + m * 16) * DM + col0;
#pragma unroll
                for (int bj = 0; bj < 2; ++bj) { const f32x4 v0 = acc[ai][bj][m][0], v1 = acc[ai][bj][m][1];
                    u32x4 w; w.x = cvt_pk_bf16(v0[0], v0[1]); w.y = cvt_pk_bf16(v0[2], v0[3]); w.z = cvt_pk_bf16(v1[0], v1[1]); w.w = cvt_pk_bf16(v1[2], v1[3]);
                    *(u32x4*)(rowp + bj * 128) = w; } }
    }
};
struct EpiSwiGLU {
    bf16_t* O;
    __device__ __forceinline__ void operator()(const f32x4 (&acc)[2][2][4][2], const pg8::Unit& u, int wr, int wc, int fr, int fq) const {
        const int row0 = u.pm * 256 + wr * 64 + fr, col0 = u.pn * 128 + wc * 32 + 8 * fq;
#pragma unroll
        for (int ai = 0; ai < 2; ++ai)
#pragma unroll
            for (int m = 0; m < 4; ++m) {
                float v[8];
#pragma unroll
                for (int n = 0; n < 2; ++n)
#pragma unroll
                    for (int j = 0; j < 4; ++j) v[n * 4 + j] = silu_f(acc[ai][0][m][n][j]) * acc[ai][1][m][n][j];
                u32x4 w; w.x = cvt_pk_bf16(v[0], v[1]); w.y = cvt_pk_bf16(v[2], v[3]); w.z = cvt_pk_bf16(v[4], v[5]); w.w = cvt_pk_bf16(v[6], v[7]);
                *(u32x4*)(O + (size_t)(row0 + ai * 128 + m * 16) * FF + col0) = w;
            }
    }
};
struct EpiDnIn {
    bf16_t* QKV; bf16_t* Z; float* BA; bf16_t* HALO;
    __device__ __forceinline__ void operator()(const f32x4 (&acc)[2][2][4][2], const pg8::Unit& u, int wr, int wc, int fr, int fq) const {
        const int row0 = u.pm * 256 + wr * 64 + fr;
#pragma unroll
        for (int ai = 0; ai < 2; ++ai)
#pragma unroll
            for (int m = 0; m < 4; ++m) {
                const int r = row0 + ai * 128 + m * 16;
#pragma unroll
                for (int bj = 0; bj < 2; ++bj) {
                    const int c0 = u.pn * 256 + bj * 128 + wc * 32 + 8 * fq;
                    const f32x4 v0 = acc[ai][bj][m][0], v1 = acc[ai][bj][m][1];
                    if (u.pn < 16) {
                        u32x4 w; w.x = cvt_pk_bf16(v0[0], v0[1]); w.y = cvt_pk_bf16(v0[2], v0[3]); w.z = cvt_pk_bf16(v1[0], v1[1]); w.w = cvt_pk_bf16(v1[2], v1[3]);
                        if (u.pn < 12) {
                            *(u32x4*)(QKV + (size_t)r * 3072 + c0) = w;
                            const int rl = r & 63;
                            if (rl >= 61) *(u32x4*)(HALO + ((size_t)(r >> 6) * 3 + (rl - 61)) * 3072 + c0) = w;
                        } else *(u32x4*)(Z + (size_t)r * 1024 + (c0 - 3072)) = w;
                    } else if (c0 < 4112) { *(f32x4*)(BA + (size_t)r * 16 + (c0 - 4096)) = v0; *(f32x4*)(BA + (size_t)r * 16 + (c0 - 4096) + 4) = v1; }
                }
            }
    }
};
struct EpiSgIn {
    bf16_t* U; bf16_t* V; const float* bias;
    __device__ __forceinline__ void operator()(const f32x4 (&acc)[2][2][4][2], const pg8::Unit& u, int wr, int wc, int fr, int fq) const {
        const int row0 = u.pm * 256 + wr * 64 + fr;
        bf16_t* base = u.pn < 8 ? U : V;
        const int cb = (u.pn < 8 ? u.pn : u.pn - 8) * 256;
        f32x4 bv[2][2];
#pragma unroll
        for (int bj = 0; bj < 2; ++bj)
#pragma unroll
            for (int n = 0; n < 2; ++n) bv[bj][n] = *(const f32x4*)(bias + u.pn * 256 + bj * 128 + wc * 32 + 8 * fq + 4 * n);
#pragma unroll
        for (int ai = 0; ai < 2; ++ai)
#pragma unroll
            for (int m = 0; m < 4; ++m) {
                const int r = row0 + ai * 128 + m * 16;
#pragma unroll
                for (int bj = 0; bj < 2; ++bj) {
                    const int c0 = cb + bj * 128 + wc * 32 + 8 * fq;
                    const f32x4 v0 = acc[ai][bj][m][0] + bv[bj][0], v1 = acc[ai][bj][m][1] + bv[bj][1];
                    const f32x2 ga = gelu_pk((f32x2){v0[0], v0[1]}), gb = gelu_pk((f32x2){v0[2], v0[3]}), gc = gelu_pk((f32x2){v1[0], v1[1]}), gd = gelu_pk((f32x2){v1[2], v1[3]});
                    u32x4 w; w.x = cvt_pk_bf16(ga.x, ga.y); w.y = cvt_pk_bf16(gb.x, gb.y); w.z = cvt_pk_bf16(gc.x, gc.y); w.w = cvt_pk_bf16(gd.x, gd.y);
                    *(u32x4*)(base + (size_t)r * 2048 + c0) = w;
                }
            }
    }
};

template <class Epi>
__device__ __forceinline__ void run_gemm(LAS unsigned char* lds, const bf16_t* A, int lda, const bf16_t* Bt, int M, int N, int K, const Epi& E) {
    pg8::Gemm g; g.A = A; g.Bt = Bt; g.M = M; g.N = N; g.K = K; g.lda = lda;
    pg8::StaticOrder S; S.init(M, N, (int)ogdim(), *(const LAS int*)(lds + LDS_WGID_OFF));
    pg8::gemm_phase<Epi>(lds, g, S, E);
}

constexpr int PREP_EARLY = 1728, PREP_TOTAL = 5664;
__device__ __forceinline__ int prep_unit_of(int v) {
    if (v < 704) return v; if (v < 1056) return 2816 + (v - 704); if (v < 1728) return 4224 + (v - 1056);
    const int w = v - 1728; if (w < 2112) return 704 + w; if (w < 3168) return 3168 + (w - 2112); return 4896 + (w - 3168);
}
__device__ __forceinline__ void prep_weights(const Params& p, LAS unsigned char* lds, int v_begin, int v_end, int worker, int n_workers) {
    LAS float* tile = (LAS float*)lds;
    const int tid = otid();
    for (int vu = v_begin + worker; vu < v_end; vu += n_workers) {
        int uu = prep_unit_of(vu), K, ldn, ncols; const float* src; bf16_t* dst; bool perm; int g2, kt;
        if (uu < 2816) { const int i = uu / 704; uu -= i * 704; K = 1024; g2 = uu >> 3; kt = uu & 7;
            const int g = 2 * g2, pn = g >> 3, bj = (g >> 2) & 1, wc = g & 3;
            src = (bj ? p.w_up : p.w_gate) + (size_t)i * 1024 * 2816 + (128 * pn + 32 * wc); ldn = 2816; ncols = 64; perm = true;
            dst = (bf16_t*)(p.ws + OFF_WGU + i * SZ_WGU);
        } else if ((uu -= 2816) < 1408) { const int i = uu / 352; uu -= i * 352; K = 2816; g2 = uu / 22; kt = uu % 22;
            src = p.w_down + (size_t)i * 2816 * 1024 + 64 * g2; ldn = 1024; ncols = 64; perm = true; dst = (bf16_t*)(p.ws + OFF_WD + i * SZ_WD);
        } else if ((uu -= 1408) < 544) { K = 1024; g2 = uu >> 3; kt = uu & 7; src = p.dn_w_in + 64 * g2; ldn = 4112; ncols = 4112 - 64 * g2; perm = true; dst = (bf16_t*)(p.ws + OFF_WDNIN);
        } else if ((uu -= 544) < 128) { K = 1024; g2 = uu >> 3; kt = uu & 7; src = p.dn_w_out + 64 * g2; ldn = 1024; ncols = 64; perm = true; dst = (bf16_t*)(p.ws + OFF_WDNOUT);
        } else if ((uu -= 128) < 512) { K = 1024; g2 = uu >> 3; kt = uu & 7; src = p.sg_w_in + 64 * g2; ldn = 4096; ncols = 64; perm = true; dst = (bf16_t*)(p.ws + OFF_WSGIN);
        } else { uu -= 512; K = 2048; g2 = uu >> 4; kt = uu & 15; src = p.sg_w_out + 64 * g2; ldn = 1024; ncols = 64; perm = true; dst = (bf16_t*)(p.ws + OFF_WSGOUT); }
        const int c4 = (tid & 15) * 4, k0 = tid >> 4, kb = kt * 128;
#pragma unroll
        for (int it = 0; it < 4; ++it) { const int k = k0 + 32 * it;
            f32x4 v = (f32x4){0.f, 0.f, 0.f, 0.f};
            if (c4 < ncols) v = *(const f32x4*)(src + (size_t)(kb + k) * ldn + c4);
            tile[k * 65 + c4] = v[0]; tile[k * 65 + c4 + 1] = v[1]; tile[k * 65 + c4 + 2] = v[2]; tile[k * 65 + c4 + 3] = v[3]; }
        __syncthreads();
#pragma unroll
        for (int it = 0; it < 2; ++it) {
            const int rho = (tid >> 4) + 32 * it, kseg = tid & 15, sc = (rho & 32) + (perm ? perm32(rho & 31) : (rho & 31));
            float v[8];
#pragma unroll
            for (int i = 0; i < 8; ++i) v[i] = tile[(kseg * 8 + i) * 65 + sc];
            u32x4 w; w.x = cvt_pk_bf16(v[0], v[1]); w.y = cvt_pk_bf16(v[2], v[3]); w.z = cvt_pk_bf16(v[4], v[5]); w.w = cvt_pk_bf16(v[6], v[7]);
            *(u32x4*)(dst + (size_t)(g2 * 64 + rho) * K + kb + kseg * 8) = w;
        }
        __syncthreads();
    }
    if (v_begin != 0) return;
    bf16_t* Ws = (bf16_t*)(p.ws + OFF_WS);
    for (int i = obid() * NTHR + tid; i < 8 * 128 * 128 / 2; i += ogdim() * NTHR) {
        const int e = i * 2, s = e & 127, t = (e >> 7) & 127;
        const f32x2 v = *(const f32x2*)(p.sg_w_s + e);
        ((unsigned*)Ws)[i] = cvt_pk_bf16(s <= t ? v.x : 0.f, (s + 1) <= t ? v.y : 0.f);
    }
}

__device__ __forceinline__ void phase_rowwise(const float* xin, float* xout, const bf16_t* y, const float* g_post, float coef, const float* g_pre, bf16_t* h) {
    const int tid_ = otid(), wid = tid_ >> 6, lane = tid_ & 63;
    for (int row0 = (obid() * 8 + wid) * 2; row0 < T; row0 += ogdim() * 16) {
        f32x4 xv[2][4]; u32x2 yv[2][4];
#pragma unroll
        for (int r = 0; r < 2; ++r)
#pragma unroll
            for (int i = 0; i < 4; ++i) { xv[r][i] = *(const f32x4*)(xin + (size_t)(row0 + r) * DM + i * 256 + lane * 4);
                if (y) yv[r][i] = *(const u32x2*)(y + (size_t)(row0 + r) * DM + i * 256 + lane * 4); }
        if (y) {
            float ss[2] = {0.f, 0.f}; f32x4 yf[2][4];
#pragma unroll
            for (int r = 0; r < 2; ++r)
#pragma unroll
                for (int i = 0; i < 4; ++i) { yf[r][i] = (f32x4){bf_lo(yv[r][i].x), bf_hi(yv[r][i].x), bf_lo(yv[r][i].y), bf_hi(yv[r][i].y)};
                    ss[r] += yf[r][i][0] * yf[r][i][0] + yf[r][i][1] * yf[r][i][1] + yf[r][i][2] * yf[r][i][2] + yf[r][i][3] * yf[r][i][3]; }
#pragma unroll
            for (int o = 32; o >= 1; o >>= 1) { ss[0] += __shfl_xor(ss[0], o); ss[1] += __shfl_xor(ss[1], o); }
#pragma unroll
            for (int r = 0; r < 2; ++r) { const float rs = rsqrtf(ss[r] * (1.0f / DM) + 1e-6f) * coef;
#pragma unroll
                for (int i = 0; i < 4; ++i) { const f32x4 gp = *(const f32x4*)(g_post + i * 256 + lane * 4); xv[r][i] += yf[r][i] * gp * rs; } }
        }
        if (xout) {
#pragma unroll
            for (int r = 0; r < 2; ++r)
#pragma unroll
                for (int i = 0; i < 4; ++i) *(f32x4*)(xout + (size_t)(row0 + r) * DM + i * 256 + lane * 4) = xv[r][i];
        }
        if (g_pre) {
            float ss[2] = {0.f, 0.f};
#pragma unroll
            for (int r = 0; r < 2; ++r)
#pragma unroll
                for (int i = 0; i < 4; ++i) ss[r] += xv[r][i][0] * xv[r][i][0] + xv[r][i][1] * xv[r][i][1] + xv[r][i][2] * xv[r][i][2] + xv[r][i][3] * xv[r][i][3];
#pragma unroll
            for (int o = 32; o >= 1; o >>= 1) { ss[0] += __shfl_xor(ss[0], o); ss[1] += __shfl_xor(ss[1], o); }
#pragma unroll
            for (int r = 0; r < 2; ++r) { const float rs = rsqrtf(ss[r] * (1.0f / DM) + 1e-6f);
#pragma unroll
                for (int i = 0; i < 4; ++i) { const f32x4 gp = *(const f32x4*)(g_pre + i * 256 + lane * 4); const f32x4 hv = xv[r][i] * gp * rs;
                    u32x2 w; w.x = cvt_pk_bf16(hv[0], hv[1]); w.y = cvt_pk_bf16(hv[2], hv[3]);
                    *(u32x2*)(h + (size_t)(row0 + r) * DM + i * 256 + lane * 4) = w; } }
        }
    }
}

constexpr int QS_LD = 136, XT_LD = 72;
constexpr int L_LM = 0, L_SC = L_LM + 64 * 64 * 4, L_QS = L_SC + 5 * 64 * 4, L_KS = L_QS + 64 * QS_LD * 2, L_VS = L_KS + 64 * QS_LD * 2, L_AT = L_VS + 64 * QS_LD * 2,
              L_XT = L_AT + 64 * XT_LD * 2, L_KD = L_XT + 256 * XT_LD * 2, L_LB = L_KD + 128 * XT_LD * 2, L_SCR = L_LB + 64 * XT_LD * 2, L_D1END = L_SCR + 16 * 256 * 4;
static_assert(L_D1END <= 160 * 1024, "LDS");

__device__ __forceinline__ bf16x8 lds_frag(LAS unsigned char* base, int ld_elems, int r0, int k0, int fr, int fq) {
    return *(const LAS bf16x8*)(base + ((r0 + fr) * ld_elems + k0 + 8 * fq) * 2);
}

#define RELAUNDER() const int tid = otid(), wid = tid >> 6, lane = tid & 63, fr = lane & 15, fq = lane >> 4; (void)wid; (void)lane; (void)fr; (void)fq
__device__ __forceinline__ void phase_dn_local(const Params& p, int half, LAS unsigned char* lds, bool dry) {
    bf16_t* QKV = (bf16_t*)(p.ws + OFF_QKV); const bf16_t* HALO = (const bf16_t*)(p.ws + OFF_HALO); const float* BA = (const float*)(p.ws + OFF_BA);
    bf16_t* Pg = (bf16_t*)(p.ws + OFF_P); bf16_t* Ng = (bf16_t*)(p.ws + OFF_N); float* GL = (float*)(p.ws + OFF_GL);
    LAS float* sc_gc = (LAS float*)(lds + L_SC); LAS float* sc_beta = sc_gc + 64; LAS float* sc_egc = sc_gc + 128; LAS float* sc_ekd = sc_gc + 192;
    LAS float* Lm = (LAS float*)(lds + L_LM);
    u32x4 xr[3][4][2]; float braw_n = 0.f, araw_n = 0.f; f32x4 cwv = (f32x4){0.f, 0.f, 0.f, 0.f};
#define D1_LOAD(ITEM) do { const int it_ = (ITEM); if (it_ < 2048) { const int lt_ = otid(); \
        const int n_ = it_ & 127, h_ = (it_ >> 7) & 7, b_ = half * 2 + (it_ >> 10), t0_ = b_ * SEQ + n_ * 64, row_ = lt_ >> 3, seg_ = lt_ & 7; \
        if (lt_ < 64) { braw_n = BA[(size_t)(t0_ + lt_) * 16 + h_]; araw_n = BA[(size_t)(t0_ + lt_) * 16 + 8 + h_]; } \
        if (lt_ >= 128) { const int e_ = (lt_ - 128) * 4; cwv = *(const f32x4*)(p.dn_conv_w + ((e_ >> 7) & 3) * 3072 + (e_ >> 9) * 1024 + h_ * 128 + (e_ & 127)); } \
        _Pragma("unroll") for (int part = 0; part < 3; ++part) _Pragma("unroll") for (int j = 0; j < 4; ++j) { \
            const int rr = row_ - 3 + j, cb = part * 1024 + h_ * 128 + seg_ * 16; \
            const bf16_t* src = (rr >= 0) ? QKV + (size_t)(t0_ + rr) * 3072 + cb : HALO + ((size_t)((n_ > 0 ? (t0_ >> 6) - 1 : 0)) * 3 + (rr + 3)) * 3072 + cb; \
            xr[part][j][0] = *(const u32x4*)src; xr[part][j][1] = *(const u32x4*)(src + 8); \
            if (rr < 0 && n_ == 0) { xr[part][j][0] = (u32x4){0u, 0u, 0u, 0u}; xr[part][j][1] = xr[part][j][0]; } } } } while (0)
    D1_LOAD(obid());
    for (int item = obid(); item < 2048; item += ogdim()) {
        const int n = item & 127, h = (item >> 7) & 7, bl = item >> 10, b = half * 2 + bl;
        const int t0 = b * SEQ + n * 64;
        const float braw = braw_n, araw = araw_n;
        {
            const int t = otid();
            if (t >= 128) *(LAS f32x4*)(lds + L_SCR + (t - 128) * 16) = cwv;
        }
        __syncthreads();
        {
            RELAUNDER();
            { LAS unsigned char* zp = lds + L_XT + (tid >> 1) * XT_LD * 2 + (tid & 1) * 64; const u32x4 z = (u32x4){0u, 0u, 0u, 0u};
              *(LAS u32x4*)zp = z; *(LAS u32x4*)(zp + 16) = z; *(LAS u32x4*)(zp + 32) = z; *(LAS u32x4*)(zp + 48) = z; }
            const int row = tid >> 3, seg = tid & 7;
#pragma unroll
            for (int part = 0; part < 3; ++part) {
                float a[16];
#pragma unroll
                for (int c = 0; c < 16; ++c) a[c] = 0.f;
#pragma unroll
                for (int j = 0; j < 4; ++j) {
                    const u32x4 x0 = xr[part][j][0], x1 = xr[part][j][1];
                    const LAS float* wj = (const LAS float*)(lds + L_SCR) + (part * 4 + j) * 128 + seg * 16;
                    const f32x4 w0 = *(const LAS f32x4*)wj, w1 = *(const LAS f32x4*)(wj + 4), w2 = *(const LAS f32x4*)(wj + 8), w3 = *(const LAS f32x4*)(wj + 12);
                    a[0] += w0[0] * bf_lo(x0.x); a[1] += w0[1] * bf_hi(x0.x); a[2] += w0[2] * bf_lo(x0.y); a[3] += w0[3] * bf_hi(x0.y);
                    a[4] += w1[0] * bf_lo(x0.z); a[5] += w1[1] * bf_hi(x0.z); a[6] += w1[2] * bf_lo(x0.w); a[7] += w1[3] * bf_hi(x0.w);
                    a[8] += w2[0] * bf_lo(x1.x); a[9] += w2[1] * bf_hi(x1.x); a[10] += w2[2] * bf_lo(x1.y); a[11] += w2[3] * bf_hi(x1.y);
                    a[12] += w3[0] * bf_lo(x1.z); a[13] += w3[1] * bf_hi(x1.z); a[14] += w3[2] * bf_lo(x1.w); a[15] += w3[3] * bf_hi(x1.w);
                }
                float ss = 0.f;
#pragma unroll
                for (int c = 0; c < 16; ++c) { a[c] = silu_f(a[c]); ss += a[c] * a[c]; }
                float scl = 1.0f;
                if (part < 2) {
                    ss += __shfl_xor(ss, 1); ss += __shfl_xor(ss, 2); ss += __shfl_xor(ss, 4);
                    scl = rsqrtf(ss + 1e-6f) * (part == 0 ? 0.08838834764831845f : 1.0f);
                }
                u32x4 o0, o1;
                o0.x = cvt_pk_bf16(a[0] * scl, a[1] * scl); o0.y = cvt_pk_bf16(a[2] * scl, a[3] * scl); o0.z = cvt_pk_bf16(a[4] * scl, a[5] * scl); o0.w = cvt_pk_bf16(a[6] * scl, a[7] * scl);
                o1.x = cvt_pk_bf16(a[8] * scl, a[9] * scl); o1.y = cvt_pk_bf16(a[10] * scl, a[11] * scl); o1.z = cvt_pk_bf16(a[12] * scl, a[13] * scl); o1.w = cvt_pk_bf16(a[14] * scl, a[15] * scl);
                LAS unsigned char* dstp = lds + (part == 0 ? L_QS : part == 1 ? L_KS : L_VS) + (row * QS_LD + seg * 16) * 2;
                *(LAS u32x4*)dstp = o0; *(LAS u32x4*)(dstp + 16) = o1;
            }
        }
        D1_LOAD(item + ogdim());
        if (otid() < 64) {
            const int lane = otid() & 63;
            const float beta = 1.0f / (1.0f + __expf(-braw));
            const float xx = araw + p.dn_dt_bias[h];
            const float sp = fmaxf(xx, 0.f) + log1pf(__expf(-fabsf(xx)));
            float g = -__expf(p.dn_a_log[h]) * sp;
#pragma unroll
            for (int o = 1; o < 64; o <<= 1) { const float t = __shfl_up(g, o); if (lane >= o) g += t; }
            const float glast = __shfl(g, 63);
            sc_gc[lane] = g; sc_beta[lane] = beta; sc_egc[lane] = __expf(g); sc_ekd[lane] = __expf(glast - g);
            if (lane == 0) GL[(b * 8 + h) * 128 + n] = __expf(glast);
        }
        __syncthreads();
        {
            RELAUNDER();
            const int kind = wid >> 2, fi = wid & 3;
            const int i = 16 * fi + fr; const float gci = sc_gc[i], bi = sc_beta[i];
            bf16x8 yf[4];
#pragma unroll
            for (int ks = 0; ks < 4; ++ks) yf[ks] = lds_frag(lds + (kind ? L_QS : L_KS), QS_LD, 16 * fi, 32 * ks, fr, fq);
            for (int fj = 0; fj < 4; ++fj) {
                f32x4 acc = (f32x4){0.f, 0.f, 0.f, 0.f};
                if (fj <= fi) {
#pragma unroll
                    for (int ks = 0; ks < 4; ++ks) acc = MF(lds_frag(lds + L_KS, QS_LD, 16 * fj, 32 * ks, fr, fq), yf[ks], acc);
                }
                const int j0 = 16 * fj + 4 * fq;
                float v[4];
#pragma unroll
                for (int r = 0; r < 4; ++r) { const int j = j0 + r; const bool keep = kind ? (j <= i) : (j < i);
                    v[r] = keep ? acc[r] * __expf(gci - sc_gc[j]) * (kind ? 1.0f : bi) : 0.f; }
                if (kind == 0) { *(LAS f32x4*)(Lm + i * 64 + j0) = (f32x4){v[0], v[1], v[2], v[3]};
                    u32x2 w; w.x = cvt_pk_bf16(v[0], v[1]); w.y = cvt_pk_bf16(v[2], v[3]); *(LAS u32x2*)(lds + L_LB + (i * XT_LD + j0) * 2) = w; }
                else { u32x2 w; w.x = cvt_pk_bf16(v[0], v[1]); w.y = cvt_pk_bf16(v[2], v[3]); *(LAS u32x2*)(lds + L_AT + (i * XT_LD + j0) * 2) = w; }
            }
            const int dk = tid & 127, cq = tid >> 7;
            float kv[16];
#pragma unroll
            for (int c = 0; c < 16; ++c) kv[c] = bf2f(*(const LAS bf16_t*)(lds + L_KS + ((16 * cq + c) * QS_LD + dk) * 2)) * sc_ekd[16 * cq + c];
            u32x4 o0, o1;
            o0.x = cvt_pk_bf16(kv[0], kv[1]); o0.y = cvt_pk_bf16(kv[2], kv[3]); o0.z = cvt_pk_bf16(kv[4], kv[5]); o0.w = cvt_pk_bf16(kv[6], kv[7]);
            o1.x = cvt_pk_bf16(kv[8], kv[9]); o1.y = cvt_pk_bf16(kv[10], kv[11]); o1.z = cvt_pk_bf16(kv[12], kv[13]); o1.w = cvt_pk_bf16(kv[14], kv[15]);
            LAS unsigned char* dstp = lds + L_KD + (dk * XT_LD + 16 * cq) * 2;
            *(LAS u32x4*)dstp = o0; *(LAS u32x4*)(dstp + 16) = o1;
        }
        __syncthreads();
#pragma unroll
        for (int I = 0; I < 4; ++I) {
            if (I > 0) {
                RELAUNDER();
                LAS float* scr = (LAS float*)(lds + L_SCR);
#pragma unroll
                for (int cfi = 0; cfi < 2; ++cfi) {
                    const int c0 = 32 * wid + 16 * cfi;
                    f32x4 acc = (f32x4){0.f, 0.f, 0.f, 0.f};
#pragma unroll
                    for (int ks = 0; ks < (I == 3 ? 2 : 1); ++ks)
                        acc = MF(lds_frag(lds + L_LB, XT_LD, 16 * I, 32 * ks, fr, fq), lds_frag(lds + L_XT, XT_LD, c0, 32 * ks, fr, fq), acc);
#pragma unroll
                    for (int r = 0; r < 4; ++r) scr[(4 * fq + r) * 256 + c0 + fr] = acc[r];
                }
                __syncthreads();
            }
            if (otid() < 256) {
                RELAUNDER();
                float x[16];
                const bool isw = tid >= 128; const int cc = tid & 127;
                LAS unsigned char* srcm = lds + (isw ? L_KS : L_VS);
                const LAS float* scr = (const LAS float*)(lds + L_SCR);
#pragma unroll
                for (int r = 0; r < 16; ++r) { const int i = 16 * I + r;
                    x[r] = bf2f(*(const LAS bf16_t*)(srcm + (i * QS_LD + cc) * 2)) * sc_beta[i] * (isw ? sc_egc[i] : 1.0f);
                    if (I > 0) x[r] -= scr[r * 256 + tid]; }
#pragma unroll
                for (int r = 1; r < 16; ++r) {
                    float sacc = x[r];
#pragma unroll
                    for (int k4 = 0; k4 < (r + 3) / 4; ++k4) {
                        const f32x4 l = *(const LAS f32x4*)(Lm + (16 * I + r) * 64 + 16 * I + 4 * k4);
                        sacc -= l[0] * x[4 * k4]; sacc -= l[1] * x[4 * k4 + 1]; sacc -= l[2] * x[4 * k4 + 2]; sacc -= l[3] * x[4 * k4 + 3];
                    }
                    x[r] = sacc;
                }
                LAS unsigned char* dstp = lds + L_XT + (tid * XT_LD + 16 * I) * 2;
                u32x4 w0, w1;
                w0.x = cvt_pk_bf16(x[0], x[1]); w0.y = cvt_pk_bf16(x[2], x[3]); w0.z = cvt_pk_bf16(x[4], x[5]); w0.w = cvt_pk_bf16(x[6], x[7]);
                w1.x = cvt_pk_bf16(x[8], x[9]); w1.y = cvt_pk_bf16(x[10], x[11]); w1.z = cvt_pk_bf16(x[12], x[13]); w1.w = cvt_pk_bf16(x[14], x[15]);
                *(LAS u32x4*)dstp = w0; *(LAS u32x4*)(dstp + 16) = w1;
            }
            __syncthreads();
        }
        {
            RELAUNDER();
            LAS unsigned char* uT = lds + L_XT; LAS unsigned char* wT = lds + L_XT + 128 * XT_LD * 2; LAS unsigned char* stg = lds + L_KS;
            const int frow = tid >> 4, fc16 = (tid & 15) * 8;
            {
                const int fi = wid & 3, cf0 = (wid >> 2) * 4, i = 16 * fi + fr;
                bf16x8 af[2];
#pragma unroll
                for (int ks = 0; ks < 2; ++ks) af[ks] = lds_frag(lds + L_AT, XT_LD, 16 * fi, 32 * ks, fr, fq);
                const float egi = sc_egc[i];
#pragma unroll
                for (int cf = 0; cf < 4; ++cf) {
                    const int c0 = 16 * (cf0 + cf);
                    f32x4 aw = (f32x4){0.f, 0.f, 0.f, 0.f}, au = aw;
#pragma unroll
                    for (int ks = 0; ks < 2; ++ks) { aw = MF(lds_frag(wT, XT_LD, c0, 32 * ks, fr, fq), af[ks], aw); au = MF(lds_frag(uT, XT_LD, c0, 32 * ks, fr, fq), af[ks], au); }
                    const u32x2 qv = *(const LAS u32x2*)(lds + L_QS + (i * QS_LD + c0 + 4 * fq) * 2);
                    u32x2 wr_, wo;
                    wr_.x = cvt_pk_bf16(bf_lo(qv.x) * egi - aw[0], bf_hi(qv.x) * egi - aw[1]); wr_.y = cvt_pk_bf16(bf_lo(qv.y) * egi - aw[2], bf_hi(qv.y) * egi - aw[3]);
                    wo.x = cvt_pk_bf16(au[0], au[1]); wo.y = cvt_pk_bf16(au[2], au[3]);
                    *(LAS u32x2*)(stg + (i * QS_LD + c0 + 4 * fq) * 2) = wr_;
                    *(LAS u32x2*)(stg + ((64 + i) * QS_LD + c0 + 4 * fq) * 2) = wo;
                }
            }
            __syncthreads();
            if (!dry) {
#pragma unroll
                for (int it = 0; it < 4; ++it) { const int row = frow + 32 * it;
                    const u32x4 v = *(const LAS u32x4*)(stg + (row * QS_LD + fc16) * 2);
                    *(u32x4*)(QKV + (size_t)(t0 + (row & 63)) * 3072 + (row >> 6) * 1024 + h * 128 + fc16) = v; }
            }
            __syncthreads();
            bf16_t* Pn = Pg + (size_t)((bl * 8 + h) * 128 + n) * 16384; bf16_t* Nn = Ng + (size_t)((bl * 8 + h) * 128 + n) * 16384;
            bf16x8 kf[2], uf[2];
#pragma unroll
            for (int ks = 0; ks < 2; ++ks) { kf[ks] = lds_frag(lds + L_KD, XT_LD, 16 * wid, 32 * ks, fr, fq); uf[ks] = lds_frag(uT, XT_LD, 16 * wid, 32 * ks, fr, fq); }
#pragma unroll
            for (int cf = 0; cf < 8; ++cf) {
                f32x4 ap = (f32x4){0.f, 0.f, 0.f, 0.f};
#pragma unroll
                for (int ks = 0; ks < 2; ++ks) ap = MF(lds_frag(wT, XT_LD, 16 * cf, 32 * ks, fr, fq), kf[ks], ap);
                u32x2 w1; w1.x = cvt_pk_bf16(ap[0], ap[1]); w1.y = cvt_pk_bf16(ap[2], ap[3]);
                *(LAS u32x2*)(stg + ((16 * wid + fr) * QS_LD + 16 * cf + 4 * fq) * 2) = w1;
            }
            __syncthreads();
            if (!dry) {
#pragma unroll
                for (int it = 0; it < 4; ++it) { const int row = frow + 32 * it;
                    *(u32x4*)(Pn + row * 128 + fc16) = *(const LAS u32x4*)(stg + (row * QS_LD + fc16) * 2); }
            }
            __syncthreads();
#pragma unroll
            for (int cf = 0; cf < 8; ++cf) {
                f32x4 an = (f32x4){0.f, 0.f, 0.f, 0.f};
#pragma unroll
                for (int ks = 0; ks < 2; ++ks) an = MF(lds_frag(lds + L_KD, XT_LD, 16 * cf, 32 * ks, fr, fq), uf[ks], an);
                u32x2 w2; w2.x = cvt_pk_bf16(an[0], an[1]); w2.y = cvt_pk_bf16(an[2], an[3]);
                *(LAS u32x2*)(stg + ((16 * wid + fr) * QS_LD + 16 * cf + 4 * fq) * 2) = w2;
            }
            __syncthreads();
            if (!dry) {
#pragma unroll
                for (int it = 0; it < 4; ++it) { const int row = frow + 32 * it;
                    *(u32x4*)(Nn + row * 128 + fc16) = *(const LAS u32x4*)(stg + (row * QS_LD + fc16) * 2); }
            }
        }
    }
}

#undef D1_LOAD
__device__ __forceinline__ void phase_dn_scan(const Params& p, int half, LAS unsigned char* lds, bool dry) {
    const int tid = otid(), wid = tid >> 6, lane = tid & 63, fr = lane & 15, fq = lane >> 4;
    const bf16_t* Pg = (const bf16_t*)(p.ws + OFF_P); bf16_t* Ng = (bf16_t*)(p.ws + OFF_N); const float* GL = (const float*)(p.ws + OFF_GL);
    constexpr int ST_LD = 136;
    for (int blk = obid(); blk < 256; blk += ogdim()) {
        const int xcd = blk & 7, j = blk >> 3;
        if (j >= 16) {
            const int mid = PREP_EARLY + (PREP_TOTAL - PREP_EARLY) / 2;
            if (!dry && j < 32) prep_weights(p, lds, half ? mid : PREP_EARLY, half ? PREP_TOTAL : mid, xcd + 8 * (j - 16), 128);
            continue;
        }
        const int slice = j & 7, bh = xcd * 2 + (j >> 3), bl = bh >> 3, h = bh & 7, b = half * 2 + bl;
        const bf16_t* Pb = Pg + (size_t)((bl * 8 + h) * 128) * 16384 + (16 * wid + fr) * 128 + 8 * fq;
        bf16_t* Nb = Ng + (size_t)((bl * 8 + h) * 128) * 16384 + (slice * 16 + fr) * 128 + 16 * wid + 4 * fq;
        const float* glb = GL + (b * 8 + h) * 128;
        __syncthreads();
        float s[4] = {0.f, 0.f, 0.f, 0.f};
        *(LAS u32x2*)(lds + (fr * ST_LD + 16 * wid + 4 * fq) * 2) = (u32x2){0u, 0u};
        bf16x8 pf[4][4]; u32x2 nf[4];
        const float gla = glb[lane], glb2 = glb[64 + lane];
#define SC_LOAD(slot, nn) do { const bf16_t* pp_ = Pb + (size_t)(nn) * 16384; const bf16_t* np_ = Nb + (size_t)(nn) * 16384; \
        asm volatile("global_load_dwordx2 %0, %1, off" : "=v"(nf[slot]) : "v"(np_) : "memory"); \
        asm volatile("global_load_dwordx4 %0, %1, off" : "=v"(pf[slot][0]) : "v"(pp_) : "memory"); \
        asm volatile("global_load_dwordx4 %0, %1, off offset:64" : "=v"(pf[slot][1]) : "v"(pp_) : "memory"); \
        asm volatile("global_load_dwordx4 %0, %1, off offset:128" : "=v"(pf[slot][2]) : "v"(pp_) : "memory"); \
        asm volatile("global_load_dwordx4 %0, %1, off offset:192" : "=v"(pf[slot][3]) : "v"(pp_) : "memory"); } while (0)
#define SC_STEP(u, n, WAITSTR) do { \
            asm volatile(WAITSTR : "+v"(nf[u]), "+v"(pf[u][0]), "+v"(pf[u][1]), "+v"(pf[u][2]), "+v"(pf[u][3]) :: "memory");     \
            asm volatile("s_waitcnt lgkmcnt(0)" ::: "memory"); __builtin_amdgcn_s_barrier(); asm volatile("" ::: "memory"); \
            LAS unsigned char* stc = lds + ((n) & 1) * (16 * ST_LD * 2); LAS unsigned char* stn = lds + (((n) + 1) & 1) * (16 * ST_LD * 2); \
            f32x4 acc0 = (f32x4){0.f, 0.f, 0.f, 0.f}, acc1 = acc0; \
            const bf16x8 sb0 = *(const LAS bf16x8*)(stc + (fr * ST_LD + 8 * fq) * 2), sb1 = *(const LAS bf16x8*)(stc + (fr * ST_LD + 32 + 8 * fq) * 2), \
                         sb2 = *(const LAS bf16x8*)(stc + (fr * ST_LD + 64 + 8 * fq) * 2), sb3 = *(const LAS bf16x8*)(stc + (fr * ST_LD + 96 + 8 * fq) * 2); \
            __builtin_amdgcn_sched_barrier(0); \
            acc0 = MF(pf[u][0], sb0, acc0); acc1 = MF(pf[u][1], sb1, acc1); acc0 = MF(pf[u][2], sb2, acc0); acc1 = MF(pf[u][3], sb3, acc1); \
            const float gl = __uint_as_float(__builtin_amdgcn_readlane(__float_as_uint((n) < 64 ? gla : glb2), (n) & 63)); \
            s[0] = gl * s[0] + bf_lo(nf[u].x) - (acc0[0] + acc1[0]); s[1] = gl * s[1] + bf_hi(nf[u].x) - (acc0[1] + acc1[1]); \
            s[2] = gl * s[2] + bf_lo(nf[u].y) - (acc0[2] + acc1[2]); s[3] = gl * s[3] + bf_hi(nf[u].y) - (acc0[3] + acc1[3]); \
            u32x2 w; w.x = cvt_pk_bf16(s[0], s[1]); w.y = cvt_pk_bf16(s[2], s[3]); \
            *(LAS u32x2*)(stn + (fr * ST_LD + 16 * wid + 4 * fq) * 2) = w; \
            if (!dry) *(u32x2*)(Nb + (size_t)(n) * 16384) = w; } while (0)
        SC_LOAD(0, 0); SC_LOAD(1, 1); SC_LOAD(2, 2); SC_LOAD(3, 3);
        for (int n4 = 0; n4 < 124; n4 += 4) {
            SC_STEP(0, n4, "s_waitcnt vmcnt(15)"); SC_LOAD(0, n4 + 4);
            SC_STEP(1, n4 + 1, "s_waitcnt vmcnt(15)"); SC_LOAD(1, n4 + 5);
            SC_STEP(2, n4 + 2, "s_waitcnt vmcnt(15)"); SC_LOAD(2, n4 + 6);
            SC_STEP(3, n4 + 3, "s_waitcnt vmcnt(15)"); SC_LOAD(3, n4 + 7);
        }
        SC_STEP(0, 124, "s_waitcnt vmcnt(0)"); SC_STEP(1, 125, "s_waitcnt vmcnt(0)"); SC_STEP(2, 126, "s_waitcnt vmcnt(0)"); SC_STEP(3, 127, "s_waitcnt vmcnt(0)");
#undef SC_STEP
#undef SC_LOAD
    }
}

__device__ __forceinline__ void phase_dn_out(const Params& p, int half, bool dry) {
    const int tid = otid(), wid = tid >> 6, lane = tid & 63, fr = lane & 15, fq = lane >> 4;
#ifdef DBG_PSRC
    bf16_t* QKV = (bf16_t*)(p.ws + OFF_QKV); const bf16_t* Ng = (const bf16_t*)(p.ws + OFF_P); const bf16_t* Z = (const bf16_t*)(p.ws + OFF_Z);
#else
    bf16_t* QKV = (bf16_t*)(p.ws + OFF_QKV); const bf16_t* Ng = (const bf16_t*)(p.ws + OFF_N); const bf16_t* Z = (const bf16_t*)(p.ws + OFF_Z);
#endif
    for (int it = obid(); it < 1024; it += ogdim()) {
        const int item = it * 2 + (wid >> 2), fi = wid & 3;
        const int n = item & 127, h = (item >> 7) & 7, bl = item >> 10, b = half * 2 + bl;
        const int t = b * SEQ + n * 64 + 16 * fi + fr;
        f32x4 acc[8];
#pragma unroll
        for (int f = 0; f < 8; ++f) acc[f] = (f32x4){0.f, 0.f, 0.f, 0.f};
        if (n > 0) {
            const bf16_t* St = Ng + (size_t)((bl * 8 + h) * 128 + n - 1) * 16384 + fr * 128 + 8 * fq;
            const bf16_t* Rp = QKV + (size_t)t * 3072 + h * 128 + 8 * fq;
#pragma unroll
            for (int ks = 0; ks < 4; ++ks) {
                const bf16x8 rf = *(const bf16x8*)(Rp + 32 * ks);
#pragma unroll
                #ifdef DBG_RONLY
                for (int f = 0; f < 8; ++f) acc[f] = MF(rf, rf, acc[f]);
#else
                for (int f = 0; f < 8; ++f) acc[f] = MF(*(const bf16x8*)(St + f * 16 * 128 + 32 * ks), rf, acc[f]);
#endif
            }
        }
        bf16_t* op = QKV + (size_t)t * 3072 + 1024 + h * 128 + 4 * fq;
        float ss = 0.f;
#pragma unroll
        for (int f = 0; f < 8; ++f) { const u32x2 o1 = *(const u32x2*)(op + 16 * f);
            acc[f][0] += bf_lo(o1.x); acc[f][1] += bf_hi(o1.x); acc[f][2] += bf_lo(o1.y); acc[f][3] += bf_hi(o1.y);
            ss += acc[f][0] * acc[f][0] + acc[f][1] * acc[f][1] + acc[f][2] * acc[f][2] + acc[f][3] * acc[f][3]; }
        ss += __shfl_xor(ss, 16); ss += __shfl_xor(ss, 32);
        const float rs = rsqrtf(ss * (1.0f / 128.0f) + 1e-6f);
        const bf16_t* zp = Z + (size_t)t * 1024 + h * 128 + 4 * fq;
#pragma unroll
        for (int f = 0; f < 8; ++f) {
            const u32x2 zv = *(const u32x2*)(zp + 16 * f); const f32x4 gn = *(const f32x4*)(p.dn_norm_g + 16 * f + 4 * fq);
            u32x2 w; w.x = cvt_pk_bf16(acc[f][0] * rs * gn[0] * silu_f(bf_lo(zv.x)), acc[f][1] * rs * gn[1] * silu_f(bf_hi(zv.x)));
            w.y = cvt_pk_bf16(acc[f][2] * rs * gn[2] * silu_f(bf_lo(zv.y)), acc[f][3] * rs * gn[3] * silu_f(bf_hi(zv.y)));
            if (!dry) *(u32x2*)(op + 16 * f) = w;
        }
    }
}

__device__ __forceinline__ void phase_sg_stats(const Params& p) {
    const int tid_ = otid(), wid = tid_ >> 6, lane = tid_ & 63;
    const bf16_t* V = (const bf16_t*)(p.ws + OFF_V); float* ST = (float*)(p.ws + OFF_STATS);
    for (int row = obid() * 8 + wid; row < T; row += ogdim() * 8) {
        float v[32]; float sum = 0.f;
#pragma unroll
        for (int i = 0; i < 4; ++i) { const u32x4 x = *(const u32x4*)(V + (size_t)row * 2048 + i * 512 + lane * 8);
            v[8 * i] = bf_lo(x.x); v[8 * i + 1] = bf_hi(x.x); v[8 * i + 2] = bf_lo(x.y); v[8 * i + 3] = bf_hi(x.y); v[8 * i + 4] = bf_lo(x.z); v[8 * i + 5] = bf_hi(x.z); v[8 * i + 6] = bf_lo(x.w); v[8 * i + 7] = bf_hi(x.w); }
#pragma unroll
        for (int i = 0; i < 32; ++i) sum += v[i];
#pragma unroll
        for (int o = 32; o >= 1; o >>= 1) sum += __shfl_xor(sum, o);
        const float mean = sum * (1.0f / 2048.0f); float q = 0.f;
#pragma unroll
        for (int i = 0; i < 32; ++i) { const float d = v[i] - mean; q += d * d; }
#pragma unroll
        for (int o = 32; o >= 1; o >>= 1) q += __shfl_xor(q, o);
        if (lane == 0) *(f32x2*)(ST + (size_t)row * 2) = (f32x2){mean, rsqrtf(q * (1.0f / 2048.0f) + 1e-5f)};
    }
}

constexpr int VT_LD = 136, UT_LD = 264, L_MX_ST = 256 * VT_LD * 2, L_MX_U = 71680, L_MX_W = L_MX_U + 128 * UT_LD * 2, L_MX_END = L_MX_W + 20 * 1024;
__host__ __device__ constexpr int mx_wbase(int tf) { return tf == 0 ? 0 : tf == 1 ? 1 : tf == 2 ? 2 : tf == 3 ? 4 : tf == 4 ? 6 : tf == 5 ? 9 : tf == 6 ? 12 : 16; }
__device__ __forceinline__ void phase_sg_mix(const Params& p, LAS unsigned char* lds, bool dry) {
    const int tid = otid(), wid = tid >> 6, lane = tid & 63, fr = lane & 15, fq = lane >> 4;
    const bf16_t* V = (const bf16_t*)(p.ws + OFF_V); bf16_t* U = (bf16_t*)(p.ws + OFF_U); const float* ST = (const float*)(p.ws + OFF_STATS);
    const bf16_t* Ws = (const bf16_t*)(p.ws + OFF_WS);
    LAS float* lst = (LAS float*)(lds + L_MX_ST);
    LAS unsigned char* ut = lds + L_MX_U;
    const int c = tid & 255, sh = tid >> 8;
    unsigned raw[64]; float stn = 0.f;
#define MX_LOAD(ITEM) do { const int it_ = (ITEM); if (it_ < 2048) { const int g_ = it_ & 7, t0_ = (it_ >> 3) * 128; \
        if (tid < 256) stn = ST[(size_t)t0_ * 2 + tid]; \
        _Pragma("unroll") for (int i = 0; i < 64; ++i) raw[i] = (unsigned)V[(size_t)(t0_ + 64 * sh + i) * 2048 + g_ * 256 + c]; } } while (0)
    int g_loaded = -1; float lg = 0.f, lb = 0.f;
    LAS float* lbs = (LAS float*)(lds + L_MX_END);
    MX_LOAD(obid());
    for (int item = obid(); item < 2048; item += ogdim()) {
        const int g = item & 7, cn = item >> 3, t0 = cn * 128;
        __syncthreads();
        if (g != g_loaded) {
            for (int q = tid; q < 20 * 64; q += NTHR) {
                const int pblk = q >> 6, row = (q & 63) >> 2, k8 = (q & 3) * 8;
                int tf = 0;
#pragma unroll
                for (int t = 1; t < 8; ++t) tf += (pblk >= mx_wbase(t)) ? 1 : 0;
                const int ks = pblk - mx_wbase(tf);
                *(LAS u32x4*)(lds + L_MX_W + pblk * 1024 + (row * 32 + k8) * 2) = *(const u32x4*)(Ws + (size_t)g * 16384 + (16 * tf + row) * 128 + 32 * ks + k8);
            }
            lg = p.sg_ln_g[g * 256 + c]; lb = p.sg_ln_b[g * 256 + c];
            if (tid < 128) lbs[tid] = p.sg_b_s[g * 128 + tid];
            g_loaded = g;
        }
        if (tid < 256) lst[tid] = stn;
#pragma unroll
        for (int k = 0; k < 8; ++k) { const int pid = otid() + 512 * k, row = pid >> 5, c16 = pid & 31;
            *(LAS u32x4*)(ut + (row * UT_LD + c16 * 8) * 2) = *(const u32x4*)(U + (size_t)(t0 + row) * 2048 + g * 256 + c16 * 8); }
        __syncthreads();
#pragma unroll
        for (int sg = 0; sg < 8; ++sg) {
            const int s0 = 64 * sh + 8 * sg; float v[8];
#pragma unroll
            for (int i = 0; i < 8; ++i) v[i] = (__uint_as_float(raw[8 * sg + i] << 16) - lst[2 * (s0 + i)]) * lst[2 * (s0 + i) + 1] * lg + lb;
            u32x4 w; w.x = cvt_pk_bf16(v[0], v[1]); w.y = cvt_pk_bf16(v[2], v[3]); w.z = cvt_pk_bf16(v[4], v[5]); w.w = cvt_pk_bf16(v[6], v[7]);
            *(LAS u32x4*)(lds + (c * VT_LD + s0) * 2) = w;
        }
        MX_LOAD(item + ogdim());
        __syncthreads();
        f32x4 acc[8][2];
#pragma unroll
        for (int tf = 0; tf < 8; ++tf) { acc[tf][0] = (f32x4){0.f, 0.f, 0.f, 0.f}; acc[tf][1] = acc[tf][0]; }
#pragma unroll
        for (int ks = 0; ks < 4; ++ks) {
            const bf16x8 v0 = lds_frag(lds, VT_LD, 32 * wid, 32 * ks, fr, fq), v1 = lds_frag(lds, VT_LD, 32 * wid + 16, 32 * ks, fr, fq);
#pragma unroll
            for (int tf = 0; tf < 8; ++tf) {
                if (32 * ks <= 16 * tf + 15) {
                    const bf16x8 wf = *(const LAS bf16x8*)(lds + L_MX_W + (mx_wbase(tf) + ks) * 1024 + (fr * 32 + 8 * fq) * 2);
                    acc[tf][0] = MF(v0, wf, acc[tf][0]); acc[tf][1] = MF(v1, wf, acc[tf][1]);
                }
            }
        }
#pragma unroll
        for (int tf = 0; tf < 8; ++tf) {
            const int t = 16 * tf + fr; const float bs = lbs[t];
#pragma unroll
            for (int cf = 0; cf < 2; ++cf) {
                LAS unsigned char* up = ut + (t * UT_LD + 32 * wid + 16 * cf + 4 * fq) * 2;
                const u32x2 uv = *(const LAS u32x2*)up;
                u32x2 w; w.x = cvt_pk_bf16(bf_lo(uv.x) * (acc[tf][cf][0] + bs), bf_hi(uv.x) * (acc[tf][cf][1] + bs));
                w.y = cvt_pk_bf16(bf_lo(uv.y) * (acc[tf][cf][2] + bs), bf_hi(uv.y) * (acc[tf][cf][3] + bs));
                *(LAS u32x2*)up = w;
            }
        }
        __syncthreads();
        if (!dry) {
#pragma unroll
            for (int k = 0; k < 8; ++k) { const int pid = otid() + 512 * k, row = pid >> 5, c16 = pid & 31;
                *(u32x4*)(U + (size_t)(t0 + row) * 2048 + g * 256 + c16 * 8) = *(const LAS u32x4*)(ut + (row * UT_LD + c16 * 8) * 2); }
        }
    }
}


#undef MX_LOAD
#define XB_TMO      128
#define XB_XCNT(j)  (256  + 64 * (j))
#define XB_XSUB(j)  (1280 + 64 * (j))
#define XB_XGEN(j)  (2304 + 64 * (j))
#define XB_TOP      3328
#define XB_TOPGEN   3392
#define XB_SPIN_CAP (1u << 18)
__device__ __forceinline__ unsigned xb_ld(unsigned* p)              { return __hip_atomic_load(p, __ATOMIC_RELAXED, __HIP_MEMORY_SCOPE_AGENT); }
__device__ __forceinline__ unsigned xb_add(unsigned* p, unsigned v) { return __hip_atomic_fetch_add(p, v, __ATOMIC_RELAXED, __HIP_MEMORY_SCOPE_AGENT); }
__device__ __forceinline__ unsigned xb_xcc_id() { return (unsigned)__builtin_amdgcn_s_getreg((3 << 11) | 20) & 0xFu; }
#define XB_SPIN(cond, bar) do { unsigned _sp = 0; while (cond) { __builtin_amdgcn_s_sleep(1); \
    if ((++_sp & 255u) == 0u) { if (xb_ld(&(bar)[XB_TMO])) break; if (_sp > XB_SPIN_CAP) { atomicAdd(&(bar)[XB_TMO], 1u); break; } } } } while (0)
struct XcdBarrier { unsigned* bar; unsigned x; volatile LAS unsigned* st; };
__device__ __forceinline__ XcdBarrier xcd_barrier_post(unsigned* bar, volatile LAS unsigned* st) {
    XcdBarrier b; b.bar = bar; b.x = xb_xcc_id(); b.st = st;
    if (threadIdx.x == 0) (void)xb_add(&bar[XB_XCNT(b.x)], 1u);
    return b;
}
__device__ __forceinline__ void xcd_barrier_complete(unsigned* bar, unsigned x, unsigned& nloc, unsigned& nx) {
    const unsigned G = gridDim.x * gridDim.y * gridDim.z;
    unsigned sum, cnt, mine, sp = 0u;
    for (;;) {
        sum = 0u; cnt = 0u; mine = 0u;
#pragma unroll
        for (unsigned j = 0; j < 16; ++j) { const unsigned c = xb_ld(&bar[XB_XCNT(j)]); sum += c; cnt += (c > 0u) ? 1u : 0u; mine = (j == x) ? c : mine; }
        if (sum == G) break;
        __builtin_amdgcn_s_sleep(1);
        if ((++sp & 255u) == 0u) { if (xb_ld(&bar[XB_TMO])) break; if (sp > XB_SPIN_CAP) { atomicAdd(&bar[XB_TMO], 1u); break; } }
    }
    nloc = mine > 0u ? mine : 1u; nx = cnt > 0u ? cnt : 1u;
}
__device__ __forceinline__ void xcd_barrier(const XcdBarrier& b) {
    asm volatile("s_waitcnt vmcnt(0)" ::: "memory");
    __syncthreads();
    if (threadIdx.x == 0) {
        unsigned* bar = b.bar;
        __builtin_amdgcn_s_waitcnt(0);
        unsigned nloc = b.st[0], nx = b.st[1];
        if (nloc == 0u) { xcd_barrier_complete(bar, b.x, nloc, nx); b.st[0] = nloc; b.st[1] = nx; }
        const unsigned old = xb_add(&bar[XB_XSUB(b.x)], 1u);
        const unsigned gen = old / nloc;
        if (old + 1u == (gen + 1u) * nloc) {
            __builtin_amdgcn_fence(__ATOMIC_RELEASE, "agent");
            asm volatile("s_waitcnt vmcnt(0)" ::: "memory");
            const unsigned og = xb_add(&bar[XB_TOP], 1u);
            const unsigned tg = og / nx;
            if (og + 1u == (tg + 1u) * nx) xb_add(&bar[XB_TOPGEN], 1u);
            else XB_SPIN(xb_ld(&bar[XB_TOPGEN]) == tg, bar);
            __builtin_amdgcn_fence(__ATOMIC_ACQUIRE, "agent");
            xb_add(&bar[XB_XGEN(b.x)], 1u);
            asm volatile("s_waitcnt vmcnt(0)" ::: "memory");
        } else {
            XB_SPIN(xb_ld(&bar[XB_XGEN(b.x)]) == gen, bar);
            __builtin_amdgcn_fence(__ATOMIC_ACQUIRE, "agent");
            asm volatile("s_waitcnt vmcnt(0)" ::: "memory");
        }
    }
    __syncthreads();
}

constexpr int NPH = 27;
__device__ __forceinline__ bool probe_rep(int ph) {
#if PROBE_REP == 1
    return ph == 1 || ph == 2 || ph == 4 || ph == 11 || ph == 13 || ph == 14 || ph == 16 || ph == 17 || ph == 19 || ph == 22 || ph == 24 || ph == 25;
#elif PROBE_REP == 2
    return ph == 0 || ph == 3 || ph == 12 || ph == 15 || ph == 18 || ph == 23 || ph == 26 || ph == 20;
#elif PROBE_REP == 3
    return ph == 5 || ph == 8 || ph == 7 || ph == 10 || ph == 21;
#elif PROBE_REP == 4
    return ph == 6 || ph == 9;
#elif PROBE_REP == 5
    return ph == 1 || ph == 13 || ph == 16 || ph == 24;
#elif PROBE_REP == 7
    return ph == 5 || ph == 8;
#elif PROBE_REP == 8
    return ph == 21;
#elif PROBE_REP == 6
    return ph == 2 || ph == 14 || ph == 17 || ph == 25;
#else
    return false;
#endif
}
__device__ __forceinline__ void run_phase(const Params& p, int ph_, LAS unsigned char* lds) {
    const int ph = ph_ & 0xff; const float rcoef = (ph_ & 0x100) ? 0.0f : 1.0f;
    unsigned char* ws = p.ws;
    bf16_t* H = (bf16_t*)(ws + OFF_H); bf16_t* Y = (bf16_t*)(ws + OFF_Y); bf16_t* ACT = (bf16_t*)(ws + OFF_ACT);
    const float* ng = p.norm_g;
    int ffn = -1, sub = 0;
    if (ph >= 1 && ph <= 3) { ffn = 0; sub = ph - 1; }
    else if (ph >= 13 && ph <= 15) { ffn = 1; sub = ph - 13; }
    else if (ph >= 16 && ph <= 18) { ffn = 2; sub = ph - 16; }
    else if (ph >= 24 && ph <= 26) { ffn = 3; sub = ph - 24; }
    if (ffn >= 0) {
        if (sub == 0) { EpiSwiGLU e; e.O = ACT; run_gemm(lds, H, DM, (const bf16_t*)(ws + OFF_WGU + ffn * SZ_WGU), T, 2 * FF, DM, e); }
        else if (sub == 1) { EpiBf16Y e; e.O = Y; run_gemm(lds, ACT, FF, (const bf16_t*)(ws + OFF_WD + ffn * SZ_WD), T, DM, FF, e); }
        else {
            const int layer = ffn >> 1, second = ffn & 1;
            const float* gpost = ng + (layer * 6 + (second ? 5 : 1)) * DM;
            const float* gpre = second ? (layer == 0 ? ng + (1 * 6 + 0) * DM : nullptr) : ng + (layer * 6 + 2) * DM;
            phase_rowwise(ffn == 0 ? p.x : (const float*)p.out, p.out, Y, gpost, (ffn == 0 ? 0.5f : 0.5f * rcoef), gpre, H);
        }
        return;
    }
    switch (ph) {
    case 0: prep_weights(p, lds, 0, PREP_EARLY, obid(), ogdim()); phase_rowwise(p.x, nullptr, nullptr, nullptr, 0.f, ng, H); break;
    case 4: { EpiDnIn e; e.QKV = (bf16_t*)(ws + OFF_QKV); e.Z = (bf16_t*)(ws + OFF_Z); e.BA = (float*)(ws + OFF_BA); e.HALO = (bf16_t*)(ws + OFF_HALO);
        run_gemm(lds, H, DM, (const bf16_t*)(ws + OFF_WDNIN), T, 4352, DM, e); } break;
    case 5: case 8: phase_dn_local(p, ph == 8 ? 1 : 0, lds, rcoef == 0.0f); break;
    case 6: case 9: phase_dn_scan(p, ph == 9 ? 1 : 0, lds, rcoef == 0.0f); break;
    case 7: case 10: phase_dn_out(p, ph == 10 ? 1 : 0, rcoef == 0.0f); break;
    case 11: { EpiBf16Y e; e.O = Y; run_gemm(lds, (const bf16_t*)(ws + OFF_QKV) + 1024, 3072, (const bf16_t*)(ws + OFF_WDNOUT), T, DM, DM, e); } break;
    case 12: phase_rowwise(p.out, p.out, Y, ng + 3 * DM, rcoef, ng + 4 * DM, H); break;
    case 19: { EpiSgIn e; e.U = (bf16_t*)(ws + OFF_U); e.V = (bf16_t*)(ws + OFF_V); e.bias = p.sg_b_in;
        run_gemm(lds, H, DM, (const bf16_t*)(ws + OFF_WSGIN), T, 4096, DM, e); } break;
    case 20: phase_sg_stats(p); break;
    case 21: phase_sg_mix(p, lds, rcoef == 0.0f); break;
    case 22: { EpiBf16Y e; e.O = Y; run_gemm(lds, (const bf16_t*)(ws + OFF_U), 2048, (const bf16_t*)(ws + OFF_WSGOUT), T, DM, 2048, e); } break;
    case 23: phase_rowwise(p.out, p.out, Y, ng + (6 + 3) * DM, rcoef, ng + (6 + 4) * DM, H); break;
    default: break;
    }
}

constexpr int LDS_BYTES = 157 * 1024;
static_assert(LDS_WGID_OFF == LDS_BYTES - 8, "logical-id word sits in the top 16 bytes of the LDS array");
static_assert(L_D1END <= LDS_BYTES && pg8::STAGE_BYTES <= LDS_BYTES && L_MX_END + 512 <= LDS_BYTES - 16 && L_MX_ST + 1024 <= L_MX_U, "LDS budget");

__global__ __launch_bounds__(512, 2) void mega(Params p, int ph_lo, int ph_hi) {
    extern __shared__ __attribute__((aligned(16))) unsigned char shm[];
    LAS unsigned char* lds = (LAS unsigned char*)shm;
#ifdef TEST_PH
    run_phase(p, TEST_PH, lds);
#else
#if MK_ONE_LAUNCH
    volatile LAS unsigned* xbst = (volatile LAS unsigned*)(lds + LDS_BYTES - 16);
    if (threadIdx.x == 0) { xbst[0] = 0u; xbst[1] = 0u; }
    __syncthreads();
    const XcdBarrier xb = xcd_barrier_post((unsigned*)(p.ws + OFF_BAR), xbst);
    if (threadIdx.x == 0) { const unsigned rk = xb_add((unsigned*)(p.ws + OFF_BAR) + 3456 + 64 * xb.x, 1u);
        xbst[2] = (xb.x < 8u && rk < 32u && gridDim.x == 256u) ? (xb.x + 8u * rk) : blockIdx.x; }
    __syncthreads();
#else
    if (threadIdx.x == 0) *(volatile LAS unsigned*)(lds + LDS_WGID_OFF) = blockIdx.x;
    __syncthreads();
#endif
    for (int ph = ph_lo; ph < ph_hi; ++ph) {
#if MK_ONE_LAUNCH
        if (ph > ph_lo) { if (ph_hi > 4096) cg::this_grid().sync(); else xcd_barrier(xb); }
#else
        if (ph > ph_lo) cg::this_grid().sync();
#endif
#ifdef PROBE_REP
        if (probe_rep(ph)) {
            Params q0 = p;
            asm volatile("" : "+s"(q0.ws), "+s"(q0.out), "+s"(q0.norm_g), "+s"(q0.x));
            run_phase(q0, ph | 0x100, lds);
            cg::this_grid().sync();
        }
#endif
        Params q = p;
        asm volatile("" : "+s"(q.ws), "+s"(q.out), "+s"(q.norm_g), "+s"(q.x));
        asm volatile("" : "+s"(q.dn_conv_w), "+s"(q.dn_a_log), "+s"(q.dn_dt_bias), "+s"(q.dn_norm_g));
        asm volatile("" : "+s"(q.sg_b_in), "+s"(q.sg_ln_g), "+s"(q.sg_ln_b), "+s"(q.sg_b_s));
        run_phase(q, ph, lds);
    }
#endif
}

extern "C" void kernel_launch(void* const* d_in, const int* in_sizes, int n_in, void* d_out, int out_size, void* d_ws, size_t ws_size, hipStream_t stream) {
    static int grid = 0;
    if (grid == 0) {
        if (n_in != 18 || in_sizes[0] != T * DM || out_size != T * DM || ws_size < WS_END) { fprintf(stderr, "kernel_launch: unexpected shapes (n_in %d, ws %zu, need %zu)\n", n_in, ws_size, (size_t)WS_END); grid = -1; return; }
        if (hipFuncSetAttribute((const void*)mega, hipFuncAttributeMaxDynamicSharedMemorySize, LDS_BYTES) != hipSuccess) { fprintf(stderr, "kernel_launch: hipFuncSetAttribute failed\n"); grid = -1; return; }
        int dev = 0, cus = 0, per_cu = 0;
        hipGetDevice(&dev); hipDeviceGetAttribute(&cus, hipDeviceAttributeMultiprocessorCount, dev);
        hipOccupancyMaxActiveBlocksPerMultiprocessor(&per_cu, (const void*)mega, NTHR, LDS_BYTES);
        if (per_cu < 1) { fprintf(stderr, "kernel_launch: occupancy query says 0 blocks per CU\n"); grid = -1; return; }
        grid = cus;
    }
    if (grid < 0) return;
    Params p{};
    p.x = (const float*)d_in[0]; p.norm_g = (const float*)d_in[1]; p.w_gate = (const float*)d_in[2]; p.w_up = (const float*)d_in[3]; p.w_down = (const float*)d_in[4];
    p.dn_w_in = (const float*)d_in[5]; p.dn_conv_w = (const float*)d_in[6]; p.dn_a_log = (const float*)d_in[7]; p.dn_dt_bias = (const float*)d_in[8]; p.dn_norm_g = (const float*)d_in[9];
    p.dn_w_out = (const float*)d_in[10]; p.sg_w_in = (const float*)d_in[11]; p.sg_b_in = (const float*)d_in[12]; p.sg_ln_g = (const float*)d_in[13]; p.sg_ln_b = (const float*)d_in[14];
    p.sg_w_s = (const float*)d_in[15]; p.sg_b_s = (const float*)d_in[16]; p.sg_w_out = (const float*)d_in[17];
    p.out = (float*)d_out; p.ws = (unsigned char*)d_ws;
#if MK_ONE_LAUNCH
    if (hipMemsetAsync((unsigned char*)d_ws + OFF_BAR, 0, (size_t)XCD_BAR_WORDS * 4, stream) != hipSuccess) { fprintf(stderr, "kernel_launch: hipMemsetAsync of the barrier words failed\n"); return; }
    int lo = 0, hi = NPH;
    void* args[] = {&p, &lo, &hi};
    hipError_t e = hipLaunchCooperativeKernel((const void*)mega, dim3(grid), dim3(NTHR), args, LDS_BYTES, stream);
    if (e != hipSuccess) fprintf(stderr, "cooperative launch failed: %s (grid %d)\n", hipGetErrorString(e), grid);
#else
    for (int ph = 0; ph < NPH; ++ph) {
#ifdef SKIP_DN
        if (ph >= 4 && ph <= 12) continue;
#endif
#ifdef DBG_NOSCAN
        if (ph == 6 || ph == 9) continue;
        if (ph >= 8 && ph <= 10) continue;
#endif
#ifdef SKIP_SG
        if (ph >= 19 && ph <= 23) continue;
#endif
        hipLaunchKernelGGL(mega, dim3(grid), dim3(NTHR), LDS_BYTES, stream, p, ph, ph + 1);
    }
#endif
}
```

```cpp
#include <hip/hip_runtime.h>
#include <hip/hip_cooperative_groups.h>
#include <cstdio>
namespace cg = cooperative_groups;

#ifndef MK_ONE_LAUNCH
#define MK_ONE_LAUNCH 1
#endif

#define LAS __attribute__((address_space(3)))
typedef unsigned short bf16_t;
typedef short bf16x8 __attribute__((ext_vector_type(8)));
typedef float f32x4 __attribute__((ext_vector_type(4)));
typedef float f32x2 __attribute__((ext_vector_type(2)));
typedef unsigned u32x4 __attribute__((ext_vector_type(4)));
typedef unsigned u32x2 __attribute__((ext_vector_type(2)));

constexpr int T = 32768, DM = 1024, FF = 2816, SEQ = 8192;
constexpr int NTHR = 512;
constexpr size_t MiB = 1048576;
constexpr size_t SZ_WGU = (size_t)5632 * 1024 * 2, SZ_WD = (size_t)1024 * 2816 * 2;
constexpr size_t OFF_WGU = 0;
constexpr size_t OFF_WD = OFF_WGU + 4 * SZ_WGU;
constexpr size_t OFF_WDNIN = OFF_WD + 4 * SZ_WD;
constexpr size_t OFF_WDNOUT = OFF_WDNIN + (size_t)4352 * 1024 * 2;
constexpr size_t OFF_WSGIN = OFF_WDNOUT + (size_t)1024 * 1024 * 2;
constexpr size_t OFF_WSGOUT = OFF_WSGIN + (size_t)4096 * 1024 * 2;
constexpr size_t OFF_WS = OFF_WSGOUT + (size_t)1024 * 2048 * 2;
constexpr size_t OFF_GL = OFF_WS + (size_t)8 * 128 * 128 * 2;
constexpr size_t OFF_STATS = OFF_GL + (size_t)4096 * 4;
constexpr size_t OFF_BAR = OFF_STATS + (size_t)T * 8;
constexpr int XCD_BAR_WORDS = 3456 + 16 * 64;
constexpr int LDS_WGID_OFF = 157 * 1024 - 8;
constexpr size_t AR = 94 * MiB;
static_assert(OFF_BAR + (size_t)XCD_BAR_WORDS * 4 <= AR, "weights region overflow");
constexpr size_t OFF_H = AR, OFF_Y = AR + 64 * MiB, OFF_ACT = AR + 192 * MiB;
constexpr size_t OFF_QKV = AR + 226 * MiB, OFF_P = AR, OFF_Z = AR + 64 * MiB, OFF_BA = AR + 128 * MiB, OFF_HALO = AR + 130 * MiB, OFF_N = AR + 139 * MiB;
constexpr size_t OFF_U = AR + 192 * MiB, OFF_V = AR + 64 * MiB;
constexpr size_t WS_END = AR + 418 * MiB;

struct Params {
    const float* x; const float* norm_g; const float* w_gate; const float* w_up; const float* w_down;
    const float* dn_w_in; const float* dn_conv_w; const float* dn_a_log; const float* dn_dt_bias; const float* dn_norm_g; const float* dn_w_out;
    const float* sg_w_in; const float* sg_b_in; const float* sg_ln_g; const float* sg_ln_b; const float* sg_w_s; const float* sg_b_s; const float* sg_w_out;
    float* out; unsigned char* ws;
};

typedef __bf16 bf16x2_t __attribute__((ext_vector_type(2)));
__device__ __forceinline__ unsigned cvt_pk_bf16(float lo, float hi) { f32x2 v = {lo, hi}; bf16x2_t r = __builtin_convertvector(v, bf16x2_t); return __builtin_bit_cast(unsigned, r); }
__device__ __forceinline__ float bf_lo(unsigned u) { return __uint_as_float(u << 16); }
__device__ __forceinline__ float bf_hi(unsigned u) { return __uint_as_float(u & 0xffff0000u); }
__device__ __forceinline__ float bf2f(bf16_t b) { return __uint_as_float(((unsigned)b) << 16); }
__device__ __forceinline__ float silu_f(float v) { return v * __builtin_amdgcn_rcpf(1.0f + __expf(-v)); }
__device__ __forceinline__ float gelu_f(float v) {
    const float av = fabsf(v), t = __builtin_amdgcn_rcpf(av * 0.2316418882f + 1.0f);
    float q = t * 0.5307027145f + (-0.7265760135f); q = q * t + 0.7107068705f; q = q * t + (-0.142248368f); q = q * t + 0.127414796f; q = q * t;
    const float e = __builtin_amdgcn_exp2f((v * v) * (-0.72134752044f));
    const float m = v * (q * e);
    return v < 0.f ? m : v - m;
}
__device__ __forceinline__ f32x2 gelu_pk(f32x2 v) {
    const f32x2 av = __builtin_elementwise_abs(v), d = av * 0.2316418882f + 1.0f;
    f32x2 t; t.x = __builtin_amdgcn_rcpf(d.x); t.y = __builtin_amdgcn_rcpf(d.y);
    f32x2 q = t * 0.5307027145f + (-0.7265760135f); q = q * t + 0.7107068705f; q = q * t + (-0.142248368f); q = q * t + 0.127414796f; q = q * t;
    const f32x2 sq = (v * v) * (-0.72134752044f);
    f32x2 e; e.x = __builtin_amdgcn_exp2f(sq.x); e.y = __builtin_amdgcn_exp2f(sq.y);
    const f32x2 m = v * (q * e), r = v - m;
    f32x2 o; o.x = v.x < 0.f ? m.x : r.x; o.y = v.y < 0.f ? m.y : r.y; return o;
}
__host__ __device__ __forceinline__ int perm32(int rho) { const int n = rho >> 4, i = rho & 15; return 8 * (i >> 2) + 4 * n + (i & 3); }
__device__ __forceinline__ int otid() { int t = threadIdx.x; asm volatile("" : "+v"(t)); return t; }
__device__ __forceinline__ int obid() { int t = (int)blockIdx.x; asm volatile("" : "+s"(t)); return t; }
__device__ __forceinline__ int ogdim() { int t = (int)gridDim.x; asm volatile("" : "+s"(t)); return t; }
#define MF(x, y, acc) __builtin_amdgcn_mfma_f32_16x16x32_bf16((x), (y), (acc), 0, 0, 0)

namespace pg8 {
constexpr int BM = 256, BK = 64, HALF = 128, HTB = HALF * BK * 2, STAGE_BYTES = 8 * HTB, NXCD = 8, WGM = 8;
__host__ __device__ __forceinline__ int lds_byte(int r, int c) { const int st = (r >> 4) * 2 + (c >> 5), rr = r & 15, cc = c & 31, ob = rr * 64 + cc * 2; return st * 1024 + (ob ^ (((ob >> 9) & 1) << 5)); }
__host__ __device__ __forceinline__ void stage_rc(int b, int& R, int& C) { const int st = b / 1024, sb = b % 1024, swz = sb ^ (((sb >> 9) & 1) << 5); R = (st >> 1) * 16 + swz / 64; C = (st & 1) * 32 + (swz % 64) / 2; }
struct Unit { int pm, pn; };
struct Gemm { const bf16_t* A; const bf16_t* Bt; int M, N, K, lda; };
struct StaticOrder {
    int nM, nN, nwg, G, c;
    __host__ __device__ void init(int M, int N, int G_, int c_) { nM = M / BM; nN = N / BM; nwg = nM * nN; G = G_; c = c_; }
    __host__ __device__ bool next(int i, Unit& u) const {
        const long L = (long)i * G + c; if (L >= nwg) return false;
        int wgid = (int)L; { const int q = nwg / NXCD, r = nwg % NXCD, xcd = wgid % NXCD, off = wgid / NXCD; wgid = (xcd < r ? xcd * (q + 1) : r * (q + 1) + (xcd - r) * q) + off; }
        const int nig = WGM * nN, gid = wgid / nig, fm = gid * WGM, gsz = (nM - fm) < WGM ? (nM - fm) : WGM;
        u.pm = fm + ((wgid % nig) % gsz); u.pn = (wgid % nig) / gsz; return true;
    }
};

template <class Epi>
__device__ __forceinline__ void gemm_phase(LAS unsigned char* lds, const Gemm g, const StaticOrder& S, const Epi& E) {
    const int tid = otid(), wid = __builtin_amdgcn_readfirstlane(tid >> 6), lane = tid & 63, wr = wid >> 2, wc = wid & 3, fr = lane & 15, fq = lane >> 4;
    const int K = g.K, nt = K / BK, lda = g.lda;
    unsigned voffA[2], voffB[2];
#pragma unroll
    for (int i = 0; i < 2; ++i) { int R, C; stage_rc(tid * 16 + i * 8192, R, C);
        voffA[i] = (unsigned)(R * lda + C) * 2u; voffB[i] = (unsigned)(R * K + C) * 2u; }
    const size_t kstep = (size_t)(BK * 2);
    const size_t hstepA = (size_t)HALF * lda * 2, hstepB = (size_t)HALF * K * 2;
    const size_t tstepA = 2 * hstepA, tstepB = 2 * hstepB;
    const unsigned ldsw = (unsigned)wid * 1024u;
    const int aoff = lds_byte(wr * 64 + fr, fq * 8), boff = lds_byte(wc * 32 + fr, fq * 8);
#define PG8_SA(b, h) (((b) * 2 + (h)) * HTB)
#define PG8_SB(b, h) ((4 + (b) * 2 + (h)) * HTB)
#define PG8_STAGE(bufoff, gbase, voff) do { _Pragma("unroll") for (int _i = 0; _i < 2; ++_i) \
        __builtin_amdgcn_global_load_lds((const unsigned*)((const char*)(gbase) + (voff)[_i]), (LAS unsigned*)(lds + (bufoff) + ldsw + _i * 8192), 16, 0, 0); } while (0)
#define PG8_LDA(dst, b, h) do { _Pragma("unroll") for (int m = 0; m < 4; ++m) _Pragma("unroll") for (int k = 0; k < 2; ++k) dst[m][k] = *(const LAS bf16x8*)(lds + PG8_SA(b, h) + aoff + m * 2048 + k * 1024); } while (0)
#define PG8_LDB(dst, b, h) do { _Pragma("unroll") for (int n = 0; n < 2; ++n) _Pragma("unroll") for (int k = 0; k < 2; ++k) dst[n][k] = *(const LAS bf16x8*)(lds + PG8_SB(b, h) + boff + n * 2048 + k * 1024); } while (0)
#define PG8_MMA(ai, bj, At, Bt) do { __builtin_amdgcn_s_setprio(1); _Pragma("unroll") for (int m = 0; m < 4; ++m) _Pragma("unroll") for (int n = 0; n < 2; ++n) _Pragma("unroll") for (int k = 0; k < 2; ++k) \
        acc[ai][bj][m][n] = __builtin_amdgcn_mfma_f32_16x16x32_bf16(Bt[n][k], At[m][k], acc[ai][bj][m][n], 0, 0, 0); __builtin_amdgcn_s_setprio(0); } while (0)
#define PG8_WAIT_V(n) asm volatile("s_waitcnt vmcnt(" #n ")" ::: "memory")
#define PG8_WAIT_L(n) asm volatile("s_waitcnt lgkmcnt(" #n ")" ::: "memory")
#define PG8_BAR __builtin_amdgcn_s_barrier()
#define PG8_SCHED __builtin_amdgcn_sched_barrier(0)
    Unit cur, nxt; int ui = 0;
    if (!S.next(0, cur)) return;
    f32x4 acc[2][2][4][2];
#pragma unroll
    for (int a = 0; a < 2; ++a)
#pragma unroll
        for (int b = 0; b < 2; ++b)
#pragma unroll
            for (int m = 0; m < 4; ++m)
#pragma unroll
                for (int n = 0; n < 2; ++n) acc[a][b][m][n] = (f32x4){0.f, 0.f, 0.f, 0.f};
    bf16x8 At[4][2], B0[2][2], B1[2][2];
    const char* cA = (const char*)g.A + (size_t)cur.pm * tstepA; const char* cB = (const char*)g.Bt + (size_t)cur.pn * tstepB;
    PG8_STAGE(PG8_SB(0, 0), cB, voffB); PG8_STAGE(PG8_SA(0, 0), cA, voffA); PG8_STAGE(PG8_SB(0, 1), cB + hstepB, voffB); PG8_STAGE(PG8_SA(0, 1), cA + hstepA, voffA);
    if (wr == 1) PG8_BAR;
    PG8_WAIT_V(4); PG8_BAR;
    PG8_STAGE(PG8_SB(1, 0), cB + kstep, voffB); PG8_STAGE(PG8_SA(1, 0), cA + kstep, voffA); PG8_STAGE(PG8_SB(1, 1), cB + hstepB + kstep, voffB);
    PG8_WAIT_V(6); PG8_BAR;
    for (;;) {
        const bool has_next = S.next(ui + 1, nxt);
        const char* nA = has_next ? (const char*)g.A + (size_t)nxt.pm * tstepA : cA; const char* nB = has_next ? (const char*)g.Bt + (size_t)nxt.pn * tstepB : cB;
        for (int t = 0; t < nt; t += 2) {
            const bool last = (t == nt - 2);
            const char* a1 = cA + (size_t)(t + 1) * kstep;
            const char* a2 = last ? nA : cA + (size_t)(t + 2) * kstep; const char* b2 = last ? nB : cB + (size_t)(t + 2) * kstep;
            const char* a3 = a2 + kstep; const char* b3 = b2 + kstep;
            PG8_LDB(B0, 0, 0); PG8_SCHED; PG8_LDA(At, 0, 0); PG8_STAGE(PG8_SA(1, 1), a1 + hstepA, voffA);
            PG8_WAIT_L(8); PG8_BAR; PG8_WAIT_L(0); PG8_MMA(0, 0, At, B0); PG8_BAR; PG8_SCHED;
            PG8_LDB(B1, 0, 1); PG8_STAGE(PG8_SB(0, 0), b2, voffB);
            PG8_BAR; PG8_WAIT_L(0); PG8_MMA(0, 1, At, B1); PG8_BAR;
            PG8_LDA(At, 0, 1); PG8_STAGE(PG8_SA(0, 0), a2, voffA);
            PG8_BAR; PG8_WAIT_L(0); PG8_MMA(1, 0, At, B0); PG8_BAR; PG8_SCHED;
            PG8_STAGE(PG8_SB(0, 1), b2 + hstepB, voffB);
            PG8_WAIT_V(6); PG8_BAR; PG8_MMA(1, 1, At, B1); PG8_BAR;
            PG8_LDB(B0, 1, 0); PG8_SCHED; PG8_LDA(At, 1, 0); PG8_STAGE(PG8_SA(0, 1), a2 + hstepA, voffA);
            PG8_WAIT_L(8); PG8_BAR; PG8_WAIT_L(0); PG8_MMA(0, 0, At, B0); PG8_BAR; PG8_SCHED;
            PG8_LDB(B1, 1, 1); PG8_STAGE(PG8_SB(1, 0), b3, voffB);
            PG8_BAR; PG8_WAIT_L(0); PG8_MMA(0, 1, At, B1); PG8_BAR;
            PG8_LDA(At, 1, 1); PG8_STAGE(PG8_SA(1, 0), a3, voffA);
            PG8_BAR; PG8_WAIT_L(0); PG8_MMA(1, 0, At, B0); PG8_BAR; PG8_SCHED;
            PG8_STAGE(PG8_SB(1, 1), b3 + hstepB, voffB);
            PG8_WAIT_V(6); PG8_BAR; PG8_MMA(1, 1, At, B1); PG8_BAR;
        }
        E(acc, cur, wr, wc, fr, fq);
        if (!has_next) break;
#pragma unroll
        for (int a = 0; a < 2; ++a)
#pragma unroll
            for (int b = 0; b < 2; ++b)
#pragma unroll
                for (int m = 0; m < 4; ++m)
#pragma unroll
                    for (int n = 0; n < 2; ++n) acc[a][b][m][n] = (f32x4){0.f, 0.f, 0.f, 0.f};
        cur = nxt; cA = nA; cB = nB; ++ui;
    }
    PG8_WAIT_V(0);
    if (wr == 0) PG8_BAR;
    PG8_BAR;
#undef PG8_SA
#undef PG8_SB
#undef PG8_STAGE
#undef PG8_LDA
#undef PG8_LDB
#undef PG8_MMA
#undef PG8_WAIT_V
#undef PG8_WAIT_L
#undef PG8_BAR
#undef PG8_SCHED
}
}

struct EpiF32 {
    float* C; int ldc;
    __device__ __forceinline__ void operator()(const f32x4 (&acc)[2][2][4][2], const pg8::Unit& u, int wr, int wc, int fr, int fq) const {
        const int row0 = u.pm * 256 + wr * 64 + fr, col0 = u.pn * 256 + wc * 32 + 4 * fq;
#pragma unroll
        for (int ai = 0; ai < 2; ++ai)
#pragma unroll
            for (int m = 0; m < 4; ++m) { float* rowp = C + (size_t)(row0 + ai * 128 + m * 16) * ldc + col0;
#pragma unroll
                for (int bj = 0; bj < 2; ++bj)
#pragma unroll
                    for (int n = 0; n < 2; ++n) *(f32x4*)(rowp + bj * 128 + n * 16) = acc[ai][bj][m][n]; }
    }
};
struct EpiBf16Y {
    bf16_t* O;
    __device__ __forceinline__ void operator()(const f32x4 (&acc)[2][2][4][2], const pg8::Unit& u, int wr, int wc, int fr, int fq) const {
        const int row0 = u.pm * 256 + wr * 64 + fr, col0 = u.pn * 256 + wc * 32 + 8 * fq;
#pragma unroll
        for (int ai = 0; ai < 2; ++ai)
#pragma unroll
            for (int m = 0; m < 4; ++m) { bf16_t* rowp = O + (size_t)(row0 + ai * 128 + m * 16) * DM + col0;
#pragma unroll
                for (int bj = 0; bj < 2; ++bj) { const f32x4 v0 = acc[ai][bj][m][0], v1 = acc[ai][bj][m][1];
                    u32x4 w; w.x = cvt_pk_bf16(v0[0], v0[1]); w.y = cvt_pk_bf16(v0[2], v0[3]); w.z = cvt_pk_bf16(v1[0], v1[1]); w.w = cvt_pk_bf16(v1[2], v1[3]);
                    *(u32x4*)(rowp + bj * 128) = w; } }
    }
};
struct EpiSwiGLU {
    bf16_t* O;
    __device__ __forceinline__ void operator()(const f32x4 (&acc)[2][2][4][2], const pg8::Unit& u, int wr, int wc, int fr, int fq) const {
        const int row0 = u.pm * 256 + wr * 64 + fr, col0 = u.pn * 128 + wc * 32 + 8 * fq;
#pragma unroll
        for (int ai = 0; ai < 2; ++ai)
#pragma unroll
            for (int m = 0; m < 4; ++m) {
                float v[8];
#pragma unroll
                for (int n = 0; n < 2; ++n)
#pragma unroll
                    for (int j = 0; j < 4; ++j) v[n * 4 + j] = silu_f(acc[ai][0][m][n][j]) * acc[ai][1][m][n][j];
                u32x4 w; w.x = cvt_pk_bf16(v[0], v[1]); w.y = cvt_pk_bf16(v[2], v[3]); w.z = cvt_pk_bf16(v[4], v[5]); w.w = cvt_pk_bf16(v[6], v[7]);
                *(u32x4*)(O + (size_t)(row0 + ai * 128 + m * 16) * FF + col0) = w;
            }
    }
};
struct EpiDnIn {
    bf16_t* QKV; bf16_t* Z; float* BA; bf16_t* HALO;
    __device__ __forceinline__ void operator()(const f32x4 (&acc)[2][2][4][2], const pg8::Unit& u, int wr, int wc, int fr, int fq) const {
        const int row0 = u.pm * 256 + wr * 64 + fr;
#pragma unroll
        for (int ai = 0; ai < 2; ++ai)
#pragma unroll
            for (int m = 0; m < 4; ++m) {
                const int r = row0 + ai * 128 + m * 16;
#pragma unroll
                for (int bj = 0; bj < 2; ++bj) {
                    const int c0 = u.pn * 256 + bj * 128 + wc * 32 + 8 * fq;
                    const f32x4 v0 = acc[ai][bj][m][0], v1 = acc[ai][bj][m][1];
                    if (u.pn < 16) {
                        u32x4 w; w.x = cvt_pk_bf16(v0[0], v0[1]); w.y = cvt_pk_bf16(v0[2], v0[3]); w.z = cvt_pk_bf16(v1[0], v1[1]); w.w = cvt_pk_bf16(v1[2], v1[3]);
                        if (u.pn < 12) {
                            *(u32x4*)(QKV + (size_t)r * 3072 + c0) = w;
                            const int rl = r & 63;
                            if (rl >= 61) *(u32x4*)(HALO + ((size_t)(r >> 6) * 3 + (rl - 61)) * 3072 + c0) = w;
                        } else *(u32x4*)(Z + (size_t)r * 1024 + (c0 - 3072)) = w;
                    } else if (c0 < 4112) { *(f32x4*)(BA + (size_t)r * 16 + (c0 - 4096)) = v0; *(f32x4*)(BA + (size_t)r * 16 + (c0 - 4096) + 4) = v1; }
                }
            }
    }
};
struct EpiSgIn {
    bf16_t* U; bf16_t* V; const float* bias;
    __device__ __forceinline__ void operator()(const f32x4 (&acc)[2][2][4][2], const pg8::Unit& u, int wr, int wc, int fr, int fq) const {
        const int row0 = u.pm * 256 + wr * 64 + fr;
        bf16_t* base = u.pn < 8 ? U : V;
        const int cb = (u.pn < 8 ? u.pn : u.pn - 8) * 256;
        f32x4 bv[2][2];
#pragma unroll
        for (int bj = 0; bj < 2; ++bj)
#pragma unroll
            for (int n = 0; n < 2; ++n) bv[bj][n] = *(const f32x4*)(bias + u.pn * 256 + bj * 128 + wc * 32 + 8 * fq + 4 * n);
#pragma unroll
        for (int ai = 0; ai < 2; ++ai)
#pragma unroll
            for (int m = 0; m < 4; ++m) {
                const int r = row0 + ai * 128 + m * 16;
#pragma unroll
                for (int bj = 0; bj < 2; ++bj) {
                    const int c0 = cb + bj * 128 + wc * 32 + 8 * fq;
                    const f32x4 v0 = acc[ai][bj][m][0] + bv[bj][0], v1 = acc[ai][bj][m][1] + bv[bj][1];
                    const f32x2 ga = gelu_pk((f32x2){v0[0], v0[1]}), gb = gelu_pk((f32x2){v0[2], v0[3]}), gc = gelu_pk((f32x2){v1[0], v1[1]}), gd = gelu_pk((f32x2){v1[2], v1[3]});
                    u32x4 w; w.x = cvt_pk_bf16(ga.x, ga.y); w.y = cvt_pk_bf16(gb.x, gb.y); w.z = cvt_pk_bf16(gc.x, gc.y); w.w = cvt_pk_bf16(gd.x, gd.y);
                    *(u32x4*)(base + (size_t)r * 2048 + c0) = w;
                }
            }
    }
};

template <class Epi>
__device__ __forceinline__ void run_gemm(LAS unsigned char* lds, const bf16_t* A, int lda, const bf16_t* Bt, int M, int N, int K, const Epi& E) {
    pg8::Gemm g; g.A = A; g.Bt = Bt; g.M = M; g.N = N; g.K = K; g.lda = lda;
    pg8::StaticOrder S; S.init(M, N, (int)ogdim(), *(const LAS int*)(lds + LDS_WGID_OFF));
    pg8::gemm_phase<Epi>(lds, g, S, E);
}

constexpr int PREP_EARLY = 1728, PREP_TOTAL = 5664;
__device__ __forceinline__ int prep_unit_of(int v) {
    if (v < 704) return v; if (v < 1056) return 2816 + (v - 704); if (v < 1728) return 4224 + (v - 1056);
    const int w = v - 1728; if (w < 2112) return 704 + w; if (w < 3168) return 3168 + (w - 2112); return 4896 + (w - 3168);
}
__device__ __forceinline__ void prep_weights(const Params& p, LAS unsigned char* lds, int v_begin, int v_end, int worker, int n_workers) {
    LAS float* tile = (LAS float*)lds;
    const int tid = otid();
    for (int vu = v_begin + worker; vu < v_end; vu += n_workers) {
        int uu = prep_unit_of(vu), K, ldn, ncols; const float* src; bf16_t* dst; bool perm; int g2, kt;
        if (uu < 2816) { const int i = uu / 704; uu -= i * 704; K = 1024; g2 = uu >> 3; kt = uu & 7;
            const int g = 2 * g2, pn = g >> 3, bj = (g >> 2) & 1, wc = g & 3;
            src = (bj ? p.w_up : p.w_gate) + (size_t)i * 1024 * 2816 + (128 * pn + 32 * wc); ldn = 2816; ncols = 64; perm = true;
            dst = (bf16_t*)(p.ws + OFF_WGU + i * SZ_WGU);
        } else if ((uu -= 2816) < 1408) { const int i = uu / 352; uu -= i * 352; K = 2816; g2 = uu / 22; kt = uu % 22;
            src = p.w_down + (size_t)i * 2816 * 1024 + 64 * g2; ldn = 1024; ncols = 64; perm = true; dst = (bf16_t*)(p.ws + OFF_WD + i * SZ_WD);
        } else if ((uu -= 1408) < 544) { K = 1024; g2 = uu >> 3; kt = uu & 7; src = p.dn_w_in + 64 * g2; ldn = 4112; ncols = 4112 - 64 * g2; perm = true; dst = (bf16_t*)(p.ws + OFF_WDNIN);
        } else if ((uu -= 544) < 128) { K = 1024; g2 = uu >> 3; kt = uu & 7; src = p.dn_w_out + 64 * g2; ldn = 1024; ncols = 64; perm = true; dst = (bf16_t*)(p.ws + OFF_WDNOUT);
        } else if ((uu -= 128) < 512) { K = 1024; g2 = uu >> 3; kt = uu & 7; src = p.sg_w_in + 64 * g2; ldn = 4096; ncols = 64; perm = true; dst = (bf16_t*)(p.ws + OFF_WSGIN);
        } else { uu -= 512; K = 2048; g2 = uu >> 4; kt = uu & 15; src = p.sg_w_out + 64 * g2; ldn = 1024; ncols = 64; perm = true; dst = (bf16_t*)(p.ws + OFF_WSGOUT); }
        const int c4 = (tid & 15) * 4, k0 = tid >> 4, kb = kt * 128;
#pragma unroll
        for (int it = 0; it < 4; ++it) { const int k = k0 + 32 * it;
            f32x4 v = (f32x4){0.f, 0.f, 0.f, 0.f};
            if (c4 < ncols) v = *(const f32x4*)(src + (size_t)(kb + k) * ldn + c4);
            tile[k * 65 + c4] = v[0]; tile[k * 65 + c4 + 1] = v[1]; tile[k * 65 + c4 + 2] = v[2]; tile[k * 65 + c4 + 3] = v[3]; }
        __syncthreads();
#pragma unroll
        for (int it = 0; it < 2; ++it) {
            const int rho = (tid >> 4) + 32 * it, kseg = tid & 15, sc = (rho & 32) + (perm ? perm32(rho & 31) : (rho & 31));
            float v[8];
#pragma unroll
            for (int i = 0; i < 8; ++i) v[i] = tile[(kseg * 8 + i) * 65 + sc];
            u32x4 w; w.x = cvt_pk_bf16(v[0], v[1]); w.y = cvt_pk_bf16(v[2], v[3]); w.z = cvt_pk_bf16(v[4], v[5]); w.w = cvt_pk_bf16(v[6], v[7]);
            *(u32x4*)(dst + (size_t)(g2 * 64 + rho) * K + kb + kseg * 8) = w;
        }
        __syncthreads();
    }
    if (v_begin != 0) return;
    bf16_t* Ws = (bf16_t*)(p.ws + OFF_WS);
    for (int i = obid() * NTHR + tid; i < 8 * 128 * 128 / 2; i += ogdim() * NTHR) {
        const int e = i * 2, s = e & 127, t = (e >> 7) & 127;
        const f32x2 v = *(const f32x2*)(p.sg_w_s + e);
        ((unsigned*)Ws)[i] = cvt_pk_bf16(s <= t ? v.x : 0.f, (s + 1) <= t ? v.y : 0.f);
    }
}

__device__ __forceinline__ void phase_rowwise(const float* xin, float* xout, const bf16_t* y, const float* g_post, float coef, const float* g_pre, bf16_t* h) {
    const int tid_ = otid(), wid = tid_ >> 6, lane = tid_ & 63;
    f32x4 gpo[4], gpr[4];
#pragma unroll
    for (int i = 0; i < 4; ++i) { gpo[i] = g_post ? *(const f32x4*)(g_post + i * 256 + lane * 4) : (f32x4){0.f, 0.f, 0.f, 0.f};
                                  gpr[i] = g_pre ? *(const f32x4*)(g_pre + i * 256 + lane * 4) : (f32x4){0.f, 0.f, 0.f, 0.f}; }
    for (int row0 = (obid() * 8 + wid) * 2; row0 < T; row0 += ogdim() * 16) {
        f32x4 xv[2][4]; u32x2 yv[2][4];
#pragma unroll
        for (int r = 0; r < 2; ++r)
#pragma unroll
            for (int i = 0; i < 4; ++i) { xv[r][i] = *(const f32x4*)(xin + (size_t)(row0 + r) * DM + i * 256 + lane * 4);
                if (y) yv[r][i] = *(const u32x2*)(y + (size_t)(row0 + r) * DM + i * 256 + lane * 4); }
        if (y) {
            float ss[2] = {0.f, 0.f}; f32x4 yf[2][4];
#pragma unroll
            for (int r = 0; r < 2; ++r)
#pragma unroll
                for (int i = 0; i < 4; ++i) { yf[r][i] = (f32x4){bf_lo(yv[r][i].x), bf_hi(yv[r][i].x), bf_lo(yv[r][i].y), bf_hi(yv[r][i].y)};
                    ss[r] += yf[r][i][0] * yf[r][i][0] + yf[r][i][1] * yf[r][i][1] + yf[r][i][2] * yf[r][i][2] + yf[r][i][3] * yf[r][i][3]; }
#pragma unroll
            for (int o = 32; o >= 1; o >>= 1) { ss[0] += __shfl_xor(ss[0], o); ss[1] += __shfl_xor(ss[1], o); }
#pragma unroll
            for (int r = 0; r < 2; ++r) { const float rs = rsqrtf(ss[r] * (1.0f / DM) + 1e-6f) * coef;
#pragma unroll
                for (int i = 0; i < 4; ++i) xv[r][i] += yf[r][i] * gpo[i] * rs; }
        }
        if (xout) {
#pragma unroll
            for (int r = 0; r < 2; ++r)
#pragma unroll
                for (int i = 0; i < 4; ++i) *(f32x4*)(xout + (size_t)(row0 + r) * DM + i * 256 + lane * 4) = xv[r][i];
        }
        if (g_pre) {
            float ss[2] = {0.f, 0.f};
#pragma unroll
            for (int r = 0; r < 2; ++r)
#pragma unroll
                for (int i = 0; i < 4; ++i) ss[r] += xv[r][i][0] * xv[r][i][0] + xv[r][i][1] * xv[r][i][1] + xv[r][i][2] * xv[r][i][2] + xv[r][i][3] * xv[r][i][3];
#pragma unroll
            for (int o = 32; o >= 1; o >>= 1) { ss[0] += __shfl_xor(ss[0], o); ss[1] += __shfl_xor(ss[1], o); }
#pragma unroll
            for (int r = 0; r < 2; ++r) { const float rs = rsqrtf(ss[r] * (1.0f / DM) + 1e-6f);
#pragma unroll
                for (int i = 0; i < 4; ++i) { const f32x4 hv = xv[r][i] * gpr[i] * rs;
                    u32x2 w; w.x = cvt_pk_bf16(hv[0], hv[1]); w.y = cvt_pk_bf16(hv[2], hv[3]);
                    *(u32x2*)(h + (size_t)(row0 + r) * DM + i * 256 + lane * 4) = w; } }
        }
    }
}

constexpr int QS_LD = 136, XT_LD = 72;
constexpr int L_LM = 0, L_SC = L_LM + 64 * 64 * 4, L_QS = L_SC + 5 * 64 * 4, L_KS = L_QS + 64 * QS_LD * 2, L_VS = L_KS + 64 * QS_LD * 2, L_AT = L_VS + 64 * QS_LD * 2,
              L_XT = L_AT + 64 * XT_LD * 2, L_KD = L_XT + 256 * XT_LD * 2, L_LB = L_KD + 128 * XT_LD * 2, L_SCR = L_LB + 64 * XT_LD * 2, L_D1END = L_SCR + 16 * 256 * 4;
static_assert(L_D1END <= 160 * 1024, "LDS");

__device__ __forceinline__ bf16x8 lds_frag(LAS unsigned char* base, int ld_elems, int r0, int k0, int fr, int fq) {
    return *(const LAS bf16x8*)(base + ((r0 + fr) * ld_elems + k0 + 8 * fq) * 2);
}

#define RELAUNDER() const int tid = otid(), wid = tid >> 6, lane = tid & 63, fr = lane & 15, fq = lane >> 4; (void)wid; (void)lane; (void)fr; (void)fq
__device__ __forceinline__ void phase_dn_local(const Params& p, int half, LAS unsigned char* lds, bool dry) {
    bf16_t* QKV = (bf16_t*)(p.ws + OFF_QKV); const bf16_t* HALO = (const bf16_t*)(p.ws + OFF_HALO); const float* BA = (const float*)(p.ws + OFF_BA);
    bf16_t* Pg = (bf16_t*)(p.ws + OFF_P); bf16_t* Ng = (bf16_t*)(p.ws + OFF_N); float* GL = (float*)(p.ws + OFF_GL);
    LAS float* sc_gc = (LAS float*)(lds + L_SC); LAS float* sc_beta = sc_gc + 64; LAS float* sc_egc = sc_gc + 128; LAS float* sc_ekd = sc_gc + 192;
    LAS float* Lm = (LAS float*)(lds + L_LM);
    u32x4 xr[3][4][2]; float braw_n = 0.f, araw_n = 0.f; f32x4 cwv = (f32x4){0.f, 0.f, 0.f, 0.f};
#define D1_LOAD(ITEM) do { const int it_ = (ITEM); if (it_ < 2048) { const int lt_ = otid(); \
        const int n_ = it_ & 127, h_ = (it_ >> 7) & 7, b_ = half * 2 + (it_ >> 10), t0_ = b_ * SEQ + n_ * 64, row_ = lt_ >> 3, seg_ = lt_ & 7; \
        if (lt_ < 64) { braw_n = BA[(size_t)(t0_ + lt_) * 16 + h_]; araw_n = BA[(size_t)(t0_ + lt_) * 16 + 8 + h_]; } \
        if (lt_ >= 128) { const int e_ = (lt_ - 128) * 4; cwv = *(const f32x4*)(p.dn_conv_w + ((e_ >> 7) & 3) * 3072 + (e_ >> 9) * 1024 + h_ * 128 + (e_ & 127)); } \
        _Pragma("unroll") for (int part = 0; part < 3; ++part) _Pragma("unroll") for (int j = 0; j < 4; ++j) { \
            const int rr = row_ - 3 + j, cb = part * 1024 + h_ * 128 + seg_ * 16; \
            const bf16_t* src = (rr >= 0) ? QKV + (size_t)(t0_ + rr) * 3072 + cb : HALO + ((size_t)((n_ > 0 ? (t0_ >> 6) - 1 : 0)) * 3 + (rr + 3)) * 3072 + cb; \
            xr[part][j][0] = *(const u32x4*)src; xr[part][j][1] = *(const u32x4*)(src + 8); \
            if (rr < 0 && n_ == 0) { xr[part][j][0] = (u32x4){0u, 0u, 0u, 0u}; xr[part][j][1] = xr[part][j][0]; } } } } while (0)
    D1_LOAD(obid());
    for (int item = obid(); item < 2048; item += ogdim()) {
        const int n = item & 127, h = (item >> 7) & 7, bl = item >> 10, b = half * 2 + bl;
        const int t0 = b * SEQ + n * 64;
        const float braw = braw_n, araw = araw_n;
        {
            const int t = otid();
            if (t >= 128) *(LAS f32x4*)(lds + L_SCR + (t - 128) * 16) = cwv;
        }
        __syncthreads();
        {
            RELAUNDER();
            { LAS unsigned char* zp = lds + L_XT + (tid >> 1) * XT_LD * 2 + (tid & 1) * 64; const u32x4 z = (u32x4){0u, 0u, 0u, 0u};
              *(LAS u32x4*)zp = z; *(LAS u32x4*)(zp + 16) = z; *(LAS u32x4*)(zp + 32) = z; *(LAS u32x4*)(zp + 48) = z; }
            const int row = tid >> 3, seg = tid & 7;
#pragma unroll
            for (int part = 0; part < 3; ++part) {
                float a[16];
#pragma unroll
                for (int c = 0; c < 16; ++c) a[c] = 0.f;
#pragma unroll
                for (int j = 0; j < 4; ++j) {
                    const u32x4 x0 = xr[part][j][0], x1 = xr[part][j][1];
                    const LAS float* wj = (const LAS float*)(lds + L_SCR) + (part * 4 + j) * 128 + seg * 16;
                    const f32x4 w0 = *(const LAS f32x4*)wj, w1 = *(const LAS f32x4*)(wj + 4), w2 = *(const LAS f32x4*)(wj + 8), w3 = *(const LAS f32x4*)(wj + 12);
                    a[0] += w0[0] * bf_lo(x0.x); a[1] += w0[1] * bf_hi(x0.x); a[2] += w0[2] * bf_lo(x0.y); a[3] += w0[3] * bf_hi(x0.y);
                    a[4] += w1[0] * bf_lo(x0.z); a[5] += w1[1] * bf_hi(x0.z); a[6] += w1[2] * bf_lo(x0.w); a[7] += w1[3] * bf_hi(x0.w);
                    a[8] += w2[0] * bf_lo(x1.x); a[9] += w2[1] * bf_hi(x1.x); a[10] += w2[2] * bf_lo(x1.y); a[11] += w2[3] * bf_hi(x1.y);
                    a[12] += w3[0] * bf_lo(x1.z); a[13] += w3[1] * bf_hi(x1.z); a[14] += w3[2] * bf_lo(x1.w); a[15] += w3[3] * bf_hi(x1.w);
                }
                float ss = 0.f;
#pragma unroll
                for (int c = 0; c < 16; ++c) { a[c] = silu_f(a[c]); ss += a[c] * a[c]; }
                float scl = 1.0f;
                if (part < 2) {
                    ss += __shfl_xor(ss, 1); ss += __shfl_xor(ss, 2); ss += __shfl_xor(ss, 4);
                    scl = rsqrtf(ss + 1e-6f) * (part == 0 ? 0.08838834764831845f : 1.0f);
                }
                u32x4 o0, o1;
                o0.x = cvt_pk_bf16(a[0] * scl, a[1] * scl); o0.y = cvt_pk_bf16(a[2] * scl, a[3] * scl); o0.z = cvt_pk_bf16(a[4] * scl, a[5] * scl); o0.w = cvt_pk_bf16(a[6] * scl, a[7] * scl);
                o1.x = cvt_pk_bf16(a[8] * scl, a[9] * scl); o1.y = cvt_pk_bf16(a[10] * scl, a[11] * scl); o1.z = cvt_pk_bf16(a[12] * scl, a[13] * scl); o1.w = cvt_pk_bf16(a[14] * scl, a[15] * scl);
                LAS unsigned char* dstp = lds + (part == 0 ? L_QS : part == 1 ? L_KS : L_VS) + (row * QS_LD + seg * 16) * 2;
                *(LAS u32x4*)dstp = o0; *(LAS u32x4*)(dstp + 16) = o1;
            }
        }
        D1_LOAD(item + ogdim());
        if (otid() < 64) {
            const int lane = otid() & 63;
            const float beta = 1.0f / (1.0f + __expf(-braw));
            const float xx = araw + p.dn_dt_bias[h];
            const float sp = fmaxf(xx, 0.f) + log1pf(__expf(-fabsf(xx)));
            float g = -__expf(p.dn_a_log[h]) * sp;
#pragma unroll
            for (int o = 1; o < 64; o <<= 1) { const float t = __shfl_up(g, o); if (lane >= o) g += t; }
            const float glast = __shfl(g, 63);
            sc_gc[lane] = g; sc_beta[lane] = beta; sc_egc[lane] = __expf(g); sc_ekd[lane] = __expf(glast - g);
            if (lane == 0) GL[(b * 8 + h) * 128 + n] = __expf(glast);
        }
        __syncthreads();
        {
            RELAUNDER();
            const int kind = wid >> 2, fi = wid & 3;
            const int i = 16 * fi + fr; const float gci = sc_gc[i], bi = sc_beta[i];
            bf16x8 yf[4];
#pragma unroll
            for (int ks = 0; ks < 4; ++ks) yf[ks] = lds_frag(lds + (kind ? L_QS : L_KS), QS_LD, 16 * fi, 32 * ks, fr, fq);
            for (int fj = 0; fj < 4; ++fj) {
                f32x4 acc = (f32x4){0.f, 0.f, 0.f, 0.f};
                if (fj <= fi) {
#pragma unroll
                    for (int ks = 0; ks < 4; ++ks) acc = MF(lds_frag(lds + L_KS, QS_LD, 16 * fj, 32 * ks, fr, fq), yf[ks], acc);
                }
                const int j0 = 16 * fj + 4 * fq;
                float v[4];
#pragma unroll
                for (int r = 0; r < 4; ++r) { const int j = j0 + r; const bool keep = kind ? (j <= i) : (j < i);
                    v[r] = keep ? acc[r] * __expf(gci - sc_gc[j]) * (kind ? 1.0f : bi) : 0.f; }
                if (kind == 0) { *(LAS f32x4*)(Lm + i * 64 + j0) = (f32x4){v[0], v[1], v[2], v[3]};
                    u32x2 w; w.x = cvt_pk_bf16(v[0], v[1]); w.y = cvt_pk_bf16(v[2], v[3]); *(LAS u32x2*)(lds + L_LB + (i * XT_LD + j0) * 2) = w; }
                else { u32x2 w; w.x = cvt_pk_bf16(v[0], v[1]); w.y = cvt_pk_bf16(v[2], v[3]); *(LAS u32x2*)(lds + L_AT + (i * XT_LD + j0) * 2) = w; }
            }
            const int dk = tid & 127, cq = tid >> 7;
            float kv[16];
#pragma unroll
            for (int c = 0; c < 16; ++c) kv[c] = bf2f(*(const LAS bf16_t*)(lds + L_KS + ((16 * cq + c) * QS_LD + dk) * 2)) * sc_ekd[16 * cq + c];
            u32x4 o0, o1;
            o0.x = cvt_pk_bf16(kv[0], kv[1]); o0.y = cvt_pk_bf16(kv[2], kv[3]); o0.z = cvt_pk_bf16(kv[4], kv[5]); o0.w = cvt_pk_bf16(kv[6], kv[7]);
            o1.x = cvt_pk_bf16(kv[8], kv[9]); o1.y = cvt_pk_bf16(kv[10], kv[11]); o1.z = cvt_pk_bf16(kv[12], kv[13]); o1.w = cvt_pk_bf16(kv[14], kv[15]);
            LAS unsigned char* dstp = lds + L_KD + (dk * XT_LD + 16 * cq) * 2;
            *(LAS u32x4*)dstp = o0; *(LAS u32x4*)(dstp + 16) = o1;
        }
        __syncthreads();
#pragma unroll
        for (int I = 0; I < 4; ++I) {
            if (I > 0) {
                RELAUNDER();
                LAS float* scr = (LAS float*)(lds + L_SCR);
#pragma unroll
                for (int cfi = 0; cfi < 2; ++cfi) {
                    const int c0 = 32 * wid + 16 * cfi;
                    f32x4 acc = (f32x4){0.f, 0.f, 0.f, 0.f};
#pragma unroll
                    for (int ks = 0; ks < (I == 3 ? 2 : 1); ++ks)
                        acc = MF(lds_frag(lds + L_LB, XT_LD, 16 * I, 32 * ks, fr, fq), lds_frag(lds + L_XT, XT_LD, c0, 32 * ks, fr, fq), acc);
#pragma unroll
                    for (int r = 0; r < 4; ++r) scr[(4 * fq + r) * 256 + c0 + fr] = acc[r];
                }
                __syncthreads();
            }
            if (otid() < 256) {
                RELAUNDER();
                float x[16];
                const bool isw = tid >= 128; const int cc = tid & 127;
                LAS unsigned char* srcm = lds + (isw ? L_KS : L_VS);
                const LAS float* scr = (const LAS float*)(lds + L_SCR);
#pragma unroll
                for (int r = 0; r < 16; ++r) { const int i = 16 * I + r;
                    x[r] = bf2f(*(const LAS bf16_t*)(srcm + (i * QS_LD + cc) * 2)) * sc_beta[i] * (isw ? sc_egc[i] : 1.0f);
                    if (I > 0) x[r] -= scr[r * 256 + tid]; }
#pragma unroll
                for (int r = 1; r < 16; ++r) {
                    float sacc = x[r];
#pragma unroll
                    for (int k4 = 0; k4 < (r + 3) / 4; ++k4) {
                        const f32x4 l = *(const LAS f32x4*)(Lm + (16 * I + r) * 64 + 16 * I + 4 * k4);
                        sacc -= l[0] * x[4 * k4]; sacc -= l[1] * x[4 * k4 + 1]; sacc -= l[2] * x[4 * k4 + 2]; sacc -= l[3] * x[4 * k4 + 3];
                    }
                    x[r] = sacc;
                }
                LAS unsigned char* dstp = lds + L_XT + (tid * XT_LD + 16 * I) * 2;
                u32x4 w0, w1;
                w0.x = cvt_pk_bf16(x[0], x[1]); w0.y = cvt_pk_bf16(x[2], x[3]); w0.z = cvt_pk_bf16(x[4], x[5]); w0.w = cvt_pk_bf16(x[6], x[7]);
                w1.x = cvt_pk_bf16(x[8], x[9]); w1.y = cvt_pk_bf16(x[10], x[11]); w1.z = cvt_pk_bf16(x[12], x[13]); w1.w = cvt_pk_bf16(x[14], x[15]);
                *(LAS u32x4*)dstp = w0; *(LAS u32x4*)(dstp + 16) = w1;
            }
            __syncthreads();
        }
        {
            RELAUNDER();
            LAS unsigned char* uT = lds + L_XT; LAS unsigned char* wT = lds + L_XT + 128 * XT_LD * 2; LAS unsigned char* stg = lds + L_KS;
            const int frow = tid >> 4, fc16 = (tid & 15) * 8;
            {
                const int fi = wid & 3, cf0 = (wid >> 2) * 4, i = 16 * fi + fr;
                bf16x8 af[2];
#pragma unroll
                for (int ks = 0; ks < 2; ++ks) af[ks] = lds_frag(lds + L_AT, XT_LD, 16 * fi, 32 * ks, fr, fq);
                const float egi = sc_egc[i];
#pragma unroll
                for (int cf = 0; cf < 4; ++cf) {
                    const int c0 = 16 * (cf0 + cf);
                    f32x4 aw = (f32x4){0.f, 0.f, 0.f, 0.f}, au = aw;
#pragma unroll
                    for (int ks = 0; ks < 2; ++ks) { aw = MF(lds_frag(wT, XT_LD, c0, 32 * ks, fr, fq), af[ks], aw); au = MF(lds_frag(uT, XT_LD, c0, 32 * ks, fr, fq), af[ks], au); }
                    const u32x2 qv = *(const LAS u32x2*)(lds + L_QS + (i * QS_LD + c0 + 4 * fq) * 2);
                    u32x2 wr_, wo;
                    wr_.x = cvt_pk_bf16(bf_lo(qv.x) * egi - aw[0], bf_hi(qv.x) * egi - aw[1]); wr_.y = cvt_pk_bf16(bf_lo(qv.y) * egi - aw[2], bf_hi(qv.y) * egi - aw[3]);
                    wo.x = cvt_pk_bf16(au[0], au[1]); wo.y = cvt_pk_bf16(au[2], au[3]);
                    *(LAS u32x2*)(stg + (i * QS_LD + c0 + 4 * fq) * 2) = wr_;
                    *(LAS u32x2*)(stg + ((64 + i) * QS_LD + c0 + 4 * fq) * 2) = wo;
                }
            }
            __syncthreads();
            if (!dry) {
#pragma unroll
                for (int it = 0; it < 4; ++it) { const int row = frow + 32 * it;
                    const u32x4 v = *(const LAS u32x4*)(stg + (row * QS_LD + fc16) * 2);
                    *(u32x4*)(QKV + (size_t)(t0 + (row & 63)) * 3072 + (row >> 6) * 1024 + h * 128 + fc16) = v; }
            }
            __syncthreads();
            bf16_t* Pn = Pg + (size_t)((bl * 8 + h) * 128 + n) * 16384; bf16_t* Nn = Ng + (size_t)((bl * 8 + h) * 128 + n) * 16384;
            bf16x8 kf[2], uf[2];
#pragma unroll
            for (int ks = 0; ks < 2; ++ks) { kf[ks] = lds_frag(lds + L_KD, XT_LD, 16 * wid, 32 * ks, fr, fq); uf[ks] = lds_frag(uT, XT_LD, 16 * wid, 32 * ks, fr, fq); }
#pragma unroll
            for (int cf = 0; cf < 8; ++cf) {
                f32x4 ap = (f32x4){0.f, 0.f, 0.f, 0.f};
#pragma unroll
                for (int ks = 0; ks < 2; ++ks) ap = MF(lds_frag(wT, XT_LD, 16 * cf, 32 * ks, fr, fq), kf[ks], ap);
                u32x2 w1; w1.x = cvt_pk_bf16(ap[0], ap[1]); w1.y = cvt_pk_bf16(ap[2], ap[3]);
                *(LAS u32x2*)(stg + ((16 * wid + fr) * QS_LD + 16 * cf + 4 * fq) * 2) = w1;
            }
            __syncthreads();
            if (!dry) {
#pragma unroll
                for (int it = 0; it < 4; ++it) { const int row = frow + 32 * it;
                    *(u32x4*)(Pn + row * 128 + fc16) = *(const LAS u32x4*)(stg + (row * QS_LD + fc16) * 2); }
            }
            __syncthreads();
#pragma unroll
            for (int cf = 0; cf < 8; ++cf) {
                f32x4 an = (f32x4){0.f, 0.f, 0.f, 0.f};
#pragma unroll
                for (int ks = 0; ks < 2; ++ks) an = MF(lds_frag(lds + L_KD, XT_LD, 16 * cf, 32 * ks, fr, fq), uf[ks], an);
                u32x2 w2; w2.x = cvt_pk_bf16(an[0], an[1]); w2.y = cvt_pk_bf16(an[2], an[3]);
                *(LAS u32x2*)(stg + ((16 * wid + fr) * QS_LD + 16 * cf + 4 * fq) * 2) = w2;
            }
            __syncthreads();
            if (!dry) {
#pragma unroll
                for (int it = 0; it < 4; ++it) { const int row = frow + 32 * it;
                    *(u32x4*)(Nn + row * 128 + fc16) = *(const LAS u32x4*)(stg + (row * QS_LD + fc16) * 2); }
            }
        }
    }
}

#undef D1_LOAD
__device__ __forceinline__ void phase_dn_scan(const Params& p, int half, LAS unsigned char* lds, bool dry) {
    const int tid = otid(), wid = tid >> 6, lane = tid & 63, fr = lane & 15, fq = lane >> 4;
    const bf16_t* Pg = (const bf16_t*)(p.ws + OFF_P); bf16_t* Ng = (bf16_t*)(p.ws + OFF_N); const float* GL = (const float*)(p.ws + OFF_GL);
    constexpr int ST_LD = 136;
    for (int blk = obid(); blk < 256; blk += ogdim()) {
        const int xcd = blk & 7, j = blk >> 3;
        if (j >= 16) {
            const int mid = PREP_EARLY + (PREP_TOTAL - PREP_EARLY) / 2;
            if (!dry && j < 32) prep_weights(p, lds, half ? mid : PREP_EARLY, half ? PREP_TOTAL : mid, xcd + 8 * (j - 16), 128);
            continue;
        }
        const int slice = j & 7, bh = xcd * 2 + (j >> 3), bl = bh >> 3, h = bh & 7, b = half * 2 + bl;
        const bf16_t* Pb = Pg + (size_t)((bl * 8 + h) * 128) * 16384 + (16 * wid + fr) * 128 + 8 * fq;
        bf16_t* Nb = Ng + (size_t)((bl * 8 + h) * 128) * 16384 + (slice * 16 + fr) * 128 + 16 * wid + 4 * fq;
        const float* glb = GL + (b * 8 + h) * 128;
        __syncthreads();
        float s[4] = {0.f, 0.f, 0.f, 0.f};
        *(LAS u32x2*)(lds + (fr * ST_LD + 16 * wid + 4 * fq) * 2) = (u32x2){0u, 0u};
        bf16x8 pf[4][4]; u32x2 nf[4];
        const float gla = glb[lane], glb2 = glb[64 + lane];
#define SC_LOAD(slot, nn) do { const bf16_t* pp_ = Pb + (size_t)(nn) * 16384; const bf16_t* np_ = Nb + (size_t)(nn) * 16384; \
        asm volatile("global_load_dwordx2 %0, %1, off" : "=v"(nf[slot]) : "v"(np_) : "memory"); \
        asm volatile("global_load_dwordx4 %0, %1, off" : "=v"(pf[slot][0]) : "v"(pp_) : "memory"); \
        asm volatile("global_load_dwordx4 %0, %1, off offset:64" : "=v"(pf[slot][1]) : "v"(pp_) : "memory"); \
        asm volatile("global_load_dwordx4 %0, %1, off offset:128" : "=v"(pf[slot][2]) : "v"(pp_) : "memory"); \
        asm volatile("global_load_dwordx4 %0, %1, off offset:192" : "=v"(pf[slot][3]) : "v"(pp_) : "memory"); } while (0)
#define SC_STEP(u, n, WAITSTR) do { \
            asm volatile(WAITSTR : "+v"(nf[u]), "+v"(pf[u][0]), "+v"(pf[u][1]), "+v"(pf[u][2]), "+v"(pf[u][3]) :: "memory");     \
            asm volatile("s_waitcnt lgkmcnt(0)" ::: "memory"); __builtin_amdgcn_s_barrier(); asm volatile("" ::: "memory"); \
            LAS unsigned char* stc = lds + ((n) & 1) * (16 * ST_LD * 2); LAS unsigned char* stn = lds + (((n) + 1) & 1) * (16 * ST_LD * 2); \
            f32x4 acc0 = (f32x4){0.f, 0.f, 0.f, 0.f}, acc1 = acc0; \
            const bf16x8 sb0 = *(const LAS bf16x8*)(stc + (fr * ST_LD + 8 * fq) * 2), sb1 = *(const LAS bf16x8*)(stc + (fr * ST_LD + 32 + 8 * fq) * 2), \
                         sb2 = *(const LAS bf16x8*)(stc + (fr * ST_LD + 64 + 8 * fq) * 2), sb3 = *(const LAS bf16x8*)(stc + (fr * ST_LD + 96 + 8 * fq) * 2); \
            __builtin_amdgcn_sched_barrier(0); \
            acc0 = MF(pf[u][0], sb0, acc0); acc1 = MF(pf[u][1], sb1, acc1); acc0 = MF(pf[u][2], sb2, acc0); acc1 = MF(pf[u][3], sb3, acc1); \
            const float gl = __uint_as_float(__builtin_amdgcn_readlane(__float_as_uint((n) < 64 ? gla : glb2), (n) & 63)); \
            s[0] = gl * s[0] + bf_lo(nf[u].x) - (acc0[0] + acc1[0]); s[1] = gl * s[1] + bf_hi(nf[u].x) - (acc0[1] + acc1[1]); \
            s[2] = gl * s[2] + bf_lo(nf[u].y) - (acc0[2] + acc1[2]); s[3] = gl * s[3] + bf_hi(nf[u].y) - (acc0[3] + acc1[3]); \
            u32x2 w; w.x = cvt_pk_bf16(s[0], s[1]); w.y = cvt_pk_bf16(s[2], s[3]); \
            *(LAS u32x2*)(stn + (fr * ST_LD + 16 * wid + 4 * fq) * 2) = w; \
            if (!dry) *(u32x2*)(Nb + (size_t)(n) * 16384) = w; } while (0)
        SC_LOAD(0, 0); SC_LOAD(1, 1); SC_LOAD(2, 2); SC_LOAD(3, 3);
        for (int n4 = 0; n4 < 124; n4 += 4) {
            SC_STEP(0, n4, "s_waitcnt vmcnt(15)"); SC_LOAD(0, n4 + 4);
            SC_STEP(1, n4 + 1, "s_waitcnt vmcnt(15)"); SC_LOAD(1, n4 + 5);
            SC_STEP(2, n4 + 2, "s_waitcnt vmcnt(15)"); SC_LOAD(2, n4 + 6);
            SC_STEP(3, n4 + 3, "s_waitcnt vmcnt(15)"); SC_LOAD(3, n4 + 7);
        }
        SC_STEP(0, 124, "s_waitcnt vmcnt(0)"); SC_STEP(1, 125, "s_waitcnt vmcnt(0)"); SC_STEP(2, 126, "s_waitcnt vmcnt(0)"); SC_STEP(3, 127, "s_waitcnt vmcnt(0)");
#undef SC_STEP
#undef SC_LOAD
    }
}

__device__ __forceinline__ void phase_dn_out(const Params& p, int half, bool dry) {
    const int tid = otid(), wid = tid >> 6, lane = tid & 63, fr = lane & 15, fq = lane >> 4;
#ifdef DBG_PSRC
    bf16_t* QKV = (bf16_t*)(p.ws + OFF_QKV); const bf16_t* Ng = (const bf16_t*)(p.ws + OFF_P); const bf16_t* Z = (const bf16_t*)(p.ws + OFF_Z);
#else
    bf16_t* QKV = (bf16_t*)(p.ws + OFF_QKV); const bf16_t* Ng = (const bf16_t*)(p.ws + OFF_N); const bf16_t* Z = (const bf16_t*)(p.ws + OFF_Z);
#endif
    for (int it = obid(); it < 1024; it += ogdim()) {
        const int item = it * 2 + (wid >> 2), fi = wid & 3;
        const int n = item & 127, h = (item >> 7) & 7, bl = item >> 10, b = half * 2 + bl;
        const int t = b * SEQ + n * 64 + 16 * fi + fr;
        f32x4 acc[8];
#pragma unroll
        for (int f = 0; f < 8; ++f) acc[f] = (f32x4){0.f, 0.f, 0.f, 0.f};
        if (n > 0) {
            const bf16_t* St = Ng + (size_t)((bl * 8 + h) * 128 + n - 1) * 16384 + fr * 128 + 8 * fq;
            const bf16_t* Rp = QKV + (size_t)t * 3072 + h * 128 + 8 * fq;
#pragma unroll
            for (int ks = 0; ks < 4; ++ks) {
                const bf16x8 rf = *(const bf16x8*)(Rp + 32 * ks);
#pragma unroll
                #ifdef DBG_RONLY
                for (int f = 0; f < 8; ++f) acc[f] = MF(rf, rf, acc[f]);
#else
                for (int f = 0; f < 8; ++f) acc[f] = MF(*(const bf16x8*)(St + f * 16 * 128 + 32 * ks), rf, acc[f]);
#endif
            }
        }
        bf16_t* op = QKV + (size_t)t * 3072 + 1024 + h * 128 + 4 * fq;
        float ss = 0.f;
#pragma unroll
        for (int f = 0; f < 8; ++f) { const u32x2 o1 = *(const u32x2*)(op + 16 * f);
            acc[f][0] += bf_lo(o1.x); acc[f][1] += bf_hi(o1.x); acc[f][2] += bf_lo(o1.y); acc[f][3] += bf_hi(o1.y);
            ss += acc[f][0] * acc[f][0] + acc[f][1] * acc[f][1] + acc[f][2] * acc[f][2] + acc[f][3] * acc[f][3]; }
        ss += __shfl_xor(ss, 16); ss += __shfl_xor(ss, 32);
        const float rs = rsqrtf(ss * (1.0f / 128.0f) + 1e-6f);
        const bf16_t* zp = Z + (size_t)t * 1024 + h * 128 + 4 * fq;
#pragma unroll
        for (int f = 0; f < 8; ++f) {
            const u32x2 zv = *(const u32x2*)(zp + 16 * f); const f32x4 gn = *(const f32x4*)(p.dn_norm_g + 16 * f + 4 * fq);
            u32x2 w; w.x = cvt_pk_bf16(acc[f][0] * rs * gn[0] * silu_f(bf_lo(zv.x)), acc[f][1] * rs * gn[1] * silu_f(bf_hi(zv.x)));
            w.y = cvt_pk_bf16(acc[f][2] * rs * gn[2] * silu_f(bf_lo(zv.y)), acc[f][3] * rs * gn[3] * silu_f(bf_hi(zv.y)));
            if (!dry) *(u32x2*)(op + 16 * f) = w;
        }
    }
}

__device__ __forceinline__ void phase_sg_stats(const Params& p) {
    const int tid_ = otid(), wid = tid_ >> 6, lane = tid_ & 63;
    const bf16_t* V = (const bf16_t*)(p.ws + OFF_V); float* ST = (float*)(p.ws + OFF_STATS);
    for (int row = obid() * 8 + wid; row < T; row += ogdim() * 8) {
        float v[32]; float sum = 0.f;
#pragma unroll
        for (int i = 0; i < 4; ++i) { const u32x4 x = *(const u32x4*)(V + (size_t)row * 2048 + i * 512 + lane * 8);
            v[8 * i] = bf_lo(x.x); v[8 * i + 1] = bf_hi(x.x); v[8 * i + 2] = bf_lo(x.y); v[8 * i + 3] = bf_hi(x.y); v[8 * i + 4] = bf_lo(x.z); v[8 * i + 5] = bf_hi(x.z); v[8 * i + 6] = bf_lo(x.w); v[8 * i + 7] = bf_hi(x.w); }
#pragma unroll
        for (int i = 0; i < 32; ++i) sum += v[i];
#pragma unroll
        for (int o = 32; o >= 1; o >>= 1) sum += __shfl_xor(sum, o);
        const float mean = sum * (1.0f / 2048.0f); float q = 0.f;
#pragma unroll
        for (int i = 0; i < 32; ++i) { const float d = v[i] - mean; q += d * d; }
#pragma unroll
        for (int o = 32; o >= 1; o >>= 1) q += __shfl_xor(q, o);
        if (lane == 0) *(f32x2*)(ST + (size_t)row * 2) = (f32x2){mean, rsqrtf(q * (1.0f / 2048.0f) + 1e-5f)};
    }
}

constexpr int VT_LD = 136, UT_LD = 264, L_MX_ST = 256 * VT_LD * 2, L_MX_U = 71680, L_MX_W = L_MX_U + 128 * UT_LD * 2, L_MX_END = L_MX_W + 20 * 1024;
__host__ __device__ constexpr int mx_wbase(int tf) { return tf == 0 ? 0 : tf == 1 ? 1 : tf == 2 ? 2 : tf == 3 ? 4 : tf == 4 ? 6 : tf == 5 ? 9 : tf == 6 ? 12 : 16; }
__device__ __forceinline__ void phase_sg_mix(const Params& p, LAS unsigned char* lds, bool dry) {
    const int tid = otid(), wid = tid >> 6, lane = tid & 63, fr = lane & 15, fq = lane >> 4;
    const bf16_t* V = (const bf16_t*)(p.ws + OFF_V); bf16_t* U = (bf16_t*)(p.ws + OFF_U); const float* ST = (const float*)(p.ws + OFF_STATS);
    const bf16_t* Ws = (const bf16_t*)(p.ws + OFF_WS);
    LAS float* lst = (LAS float*)(lds + L_MX_ST);
    LAS unsigned char* ut = lds + L_MX_U;
    const int c = tid & 255, sh = tid >> 8;
    unsigned raw[64]; float stn = 0.f;
#define MX_LOAD(ITEM) do { const int it_ = (ITEM); if (it_ < 2048) { const int g_ = it_ & 7, t0_ = (it_ >> 3) * 128; \
        if (tid < 256) stn = ST[(size_t)t0_ * 2 + tid]; \
        _Pragma("unroll") for (int i = 0; i < 64; ++i) raw[i] = (unsigned)V[(size_t)(t0_ + 64 * sh + i) * 2048 + g_ * 256 + c]; } } while (0)
    int g_loaded = -1; float lg = 0.f, lb = 0.f;
    LAS float* lbs = (LAS float*)(lds + L_MX_END);
    MX_LOAD(obid());
    for (int item = obid(); item < 2048; item += ogdim()) {
        const int g = item & 7, cn = item >> 3, t0 = cn * 128;
        __syncthreads();
        if (g != g_loaded) {
            for (int q = tid; q < 20 * 64; q += NTHR) {
                const int pblk = q >> 6, row = (q & 63) >> 2, k8 = (q & 3) * 8;
                int tf = 0;
#pragma unroll
                for (int t = 1; t < 8; ++t) tf += (pblk >= mx_wbase(t)) ? 1 : 0;
                const int ks = pblk - mx_wbase(tf);
                *(LAS u32x4*)(lds + L_MX_W + pblk * 1024 + (row * 32 + k8) * 2) = *(const u32x4*)(Ws + (size_t)g * 16384 + (16 * tf + row) * 128 + 32 * ks + k8);
            }
            lg = p.sg_ln_g[g * 256 + c]; lb = p.sg_ln_b[g * 256 + c];
            if (tid < 128) lbs[tid] = p.sg_b_s[g * 128 + tid];
            g_loaded = g;
        }
        if (tid < 256) lst[tid] = stn;
#pragma unroll
        for (int k = 0; k < 8; ++k) { const int pid = otid() + 512 * k, row = pid >> 5, c16 = pid & 31;
            *(LAS u32x4*)(ut + (row * UT_LD + c16 * 8) * 2) = *(const u32x4*)(U + (size_t)(t0 + row) * 2048 + g * 256 + c16 * 8); }
        __syncthreads();
#pragma unroll
        for (int sg = 0; sg < 8; ++sg) {
            const int s0 = 64 * sh + 8 * sg; float v[8];
#pragma unroll
            for (int i = 0; i < 8; ++i) v[i] = (__uint_as_float(raw[8 * sg + i] << 16) - lst[2 * (s0 + i)]) * lst[2 * (s0 + i) + 1] * lg + lb;
            u32x4 w; w.x = cvt_pk_bf16(v[0], v[1]); w.y = cvt_pk_bf16(v[2], v[3]); w.z = cvt_pk_bf16(v[4], v[5]); w.w = cvt_pk_bf16(v[6], v[7]);
            *(LAS u32x4*)(lds + (c * VT_LD + s0) * 2) = w;
        }
        MX_LOAD(item + ogdim());
        __syncthreads();
        f32x4 acc[8][2];
#pragma unroll
        for (int tf = 0; tf < 8; ++tf) { acc[tf][0] = (f32x4){0.f, 0.f, 0.f, 0.f}; acc[tf][1] = acc[tf][0]; }
#pragma unroll
        for (int ks = 0; ks < 4; ++ks) {
            const bf16x8 v0 = lds_frag(lds, VT_LD, 32 * wid, 32 * ks, fr, fq), v1 = lds_frag(lds, VT_LD, 32 * wid + 16, 32 * ks, fr, fq);
#pragma unroll
            for (int tf = 0; tf < 8; ++tf) {
                if (32 * ks <= 16 * tf + 15) {
                    const bf16x8 wf = *(const LAS bf16x8*)(lds + L_MX_W + (mx_wbase(tf) + ks) * 1024 + (fr * 32 + 8 * fq) * 2);
                    acc[tf][0] = MF(v0, wf, acc[tf][0]); acc[tf][1] = MF(v1, wf, acc[tf][1]);
                }
            }
        }
#pragma unroll
        for (int tf = 0; tf < 8; ++tf) {
            const int t = 16 * tf + fr; const float bs = lbs[t];
#pragma unroll
            for (int cf = 0; cf < 2; ++cf) {
                LAS unsigned char* up = ut + (t * UT_LD + 32 * wid + 16 * cf + 4 * fq) * 2;
                const u32x2 uv = *(const LAS u32x2*)up;
                u32x2 w; w.x = cvt_pk_bf16(bf_lo(uv.x) * (acc[tf][cf][0] + bs), bf_hi(uv.x) * (acc[tf][cf][1] + bs));
                w.y = cvt_pk_bf16(bf_lo(uv.y) * (acc[tf][cf][2] + bs), bf_hi(uv.y) * (acc[tf][cf][3] + bs));
                *(LAS u32x2*)up = w;
            }
        }
        __syncthreads();
        if (!dry) {
#pragma unroll
            for (int k = 0; k < 8; ++k) { const int pid = otid() + 512 * k, row = pid >> 5, c16 = pid & 31;
                *(u32x4*)(U + (size_t)(t0 + row) * 2048 + g * 256 + c16 * 8) = *(const LAS u32x4*)(ut + (row * UT_LD + c16 * 8) * 2); }
        }
    }
}


#undef MX_LOAD
#define XB_TMO      128
#define XB_XCNT(j)  (256  + 64 * (j))
#define XB_XSUB(j)  (1280 + 64 * (j))
#define XB_XGEN(j)  (2304 + 64 * (j))
#define XB_TOP      3328
#define XB_TOPGEN   3392
#define XB_SPIN_CAP (1u << 18)
__device__ __forceinline__ unsigned xb_ld(unsigned* p)              { return __hip_atomic_load(p, __ATOMIC_RELAXED, __HIP_MEMORY_SCOPE_AGENT); }
__device__ __forceinline__ unsigned xb_add(unsigned* p, unsigned v) { return __hip_atomic_fetch_add(p, v, __ATOMIC_RELAXED, __HIP_MEMORY_SCOPE_AGENT); }
__device__ __forceinline__ unsigned xb_xcc_id() { return (unsigned)__builtin_amdgcn_s_getreg((3 << 11) | 20) & 0xFu; }
#define XB_SPIN(cond, bar) do { unsigned _sp = 0; while (cond) { __builtin_amdgcn_s_sleep(1); \
    if ((++_sp & 255u) == 0u) { if (xb_ld(&(bar)[XB_TMO])) break; if (_sp > XB_SPIN_CAP) { atomicAdd(&(bar)[XB_TMO], 1u); break; } } } } while (0)
struct XcdBarrier { unsigned* bar; unsigned x; volatile LAS unsigned* st; };
__device__ __forceinline__ XcdBarrier xcd_barrier_post(unsigned* bar, volatile LAS unsigned* st) {
    XcdBarrier b; b.bar = bar; b.x = xb_xcc_id(); b.st = st;
    if (threadIdx.x == 0) (void)xb_add(&bar[XB_XCNT(b.x)], 1u);
    return b;
}
__device__ __forceinline__ void xcd_barrier_complete(unsigned* bar, unsigned x, unsigned& nloc, unsigned& nx) {
    const unsigned G = gridDim.x * gridDim.y * gridDim.z;
    unsigned sum, cnt, mine, sp = 0u;
    for (;;) {
        sum = 0u; cnt = 0u; mine = 0u;
#pragma unroll
        for (unsigned j = 0; j < 16; ++j) { const unsigned c = xb_ld(&bar[XB_XCNT(j)]); sum += c; cnt += (c > 0u) ? 1u : 0u; mine = (j == x) ? c : mine; }
        if (sum == G) break;
        __builtin_amdgcn_s_sleep(1);
        if ((++sp & 255u) == 0u) { if (xb_ld(&bar[XB_TMO])) break; if (sp > XB_SPIN_CAP) { atomicAdd(&bar[XB_TMO], 1u); break; } }
    }
    nloc = mine > 0u ? mine : 1u; nx = cnt > 0u ? cnt : 1u;
}
__device__ __forceinline__ void xcd_barrier(const XcdBarrier& b) {
    asm volatile("s_waitcnt vmcnt(0)" ::: "memory");
    __syncthreads();
    if (threadIdx.x == 0) {
        unsigned* bar = b.bar;
        __builtin_amdgcn_s_waitcnt(0);
        unsigned nloc = b.st[0], nx = b.st[1];
        if (nloc == 0u) { xcd_barrier_complete(bar, b.x, nloc, nx); b.st[0] = nloc; b.st[1] = nx; }
        const unsigned old = xb_add(&bar[XB_XSUB(b.x)], 1u);
        const unsigned gen = old / nloc;
        if (old + 1u == (gen + 1u) * nloc) {
            __builtin_amdgcn_fence(__ATOMIC_RELEASE, "agent");
            asm volatile("s_waitcnt vmcnt(0)" ::: "memory");
            const unsigned og = xb_add(&bar[XB_TOP], 1u);
            const unsigned tg = og / nx;
            if (og + 1u == (tg + 1u) * nx) xb_add(&bar[XB_TOPGEN], 1u);
            else XB_SPIN(xb_ld(&bar[XB_TOPGEN]) == tg, bar);
            __builtin_amdgcn_fence(__ATOMIC_ACQUIRE, "agent");
            xb_add(&bar[XB_XGEN(b.x)], 1u);
            asm volatile("s_waitcnt vmcnt(0)" ::: "memory");
        } else {
            XB_SPIN(xb_ld(&bar[XB_XGEN(b.x)]) == gen, bar);
            __builtin_amdgcn_fence(__ATOMIC_ACQUIRE, "agent");
            asm volatile("s_waitcnt vmcnt(0)" ::: "memory");
        }
    }
    __syncthreads();
}

constexpr int NPH = 27;
__device__ __forceinline__ bool probe_rep(int ph) {
#if PROBE_REP == 1
    return ph == 1 || ph == 2 || ph == 4 || ph == 11 || ph == 13 || ph == 14 || ph == 16 || ph == 17 || ph == 19 || ph == 22 || ph == 24 || ph == 25;
#elif PROBE_REP == 2
    return ph == 0 || ph == 3 || ph == 12 || ph == 15 || ph == 18 || ph == 23 || ph == 26 || ph == 20;
#elif PROBE_REP == 3
    return ph == 5 || ph == 8 || ph == 7 || ph == 10 || ph == 21;
#elif PROBE_REP == 4
    return ph == 6 || ph == 9;
#elif PROBE_REP == 5
    return ph == 1 || ph == 13 || ph == 16 || ph == 24;
#elif PROBE_REP == 7
    return ph == 5 || ph == 8;
#elif PROBE_REP == 8
    return ph == 21;
#elif PROBE_REP == 6
    return ph == 2 || ph == 14 || ph == 17 || ph == 25;
#else
    return false;
#endif
}
__device__ __forceinline__ void run_phase(const Params& p, int ph_, LAS unsigned char* lds) {
    const int ph = ph_ & 0xff; const float rcoef = (ph_ & 0x100) ? 0.0f : 1.0f;
    unsigned char* ws = p.ws;
    bf16_t* H = (bf16_t*)(ws + OFF_H); bf16_t* Y = (bf16_t*)(ws + OFF_Y); bf16_t* ACT = (bf16_t*)(ws + OFF_ACT);
    const float* ng = p.norm_g;
    int ffn = -1, sub = 0;
    if (ph >= 1 && ph <= 3) { ffn = 0; sub = ph - 1; }
    else if (ph >= 13 && ph <= 15) { ffn = 1; sub = ph - 13; }
    else if (ph >= 16 && ph <= 18) { ffn = 2; sub = ph - 16; }
    else if (ph >= 24 && ph <= 26) { ffn = 3; sub = ph - 24; }
    if (ffn >= 0) {
        if (sub == 0) { EpiSwiGLU e; e.O = ACT; run_gemm(lds, H, DM, (const bf16_t*)(ws + OFF_WGU + ffn * SZ_WGU), T, 2 * FF, DM, e); }
        else if (sub == 1) { EpiBf16Y e; e.O = Y; run_gemm(lds, ACT, FF, (const bf16_t*)(ws + OFF_WD + ffn * SZ_WD), T, DM, FF, e); }
        else {
            const int layer = ffn >> 1, second = ffn & 1;
            const float* gpost = ng + (layer * 6 + (second ? 5 : 1)) * DM;
            const float* gpre = second ? (layer == 0 ? ng + (1 * 6 + 0) * DM : nullptr) : ng + (layer * 6 + 2) * DM;
            phase_rowwise(ffn == 0 ? p.x : (const float*)p.out, p.out, Y, gpost, (ffn == 0 ? 0.5f : 0.5f * rcoef), gpre, H);
        }
        return;
    }
    switch (ph) {
    case 0: prep_weights(p, lds, 0, PREP_EARLY, obid(), ogdim()); phase_rowwise(p.x, nullptr, nullptr, nullptr, 0.f, ng, H); break;
    case 4: { EpiDnIn e; e.QKV = (bf16_t*)(ws + OFF_QKV); e.Z = (bf16_t*)(ws + OFF_Z); e.BA = (float*)(ws + OFF_BA); e.HALO = (bf16_t*)(ws + OFF_HALO);
        run_gemm(lds, H, DM, (const bf16_t*)(ws + OFF_WDNIN), T, 4352, DM, e); } break;
    case 5: case 8: phase_dn_local(p, ph == 8 ? 1 : 0, lds, rcoef == 0.0f); break;
    case 6: case 9: phase_dn_scan(p, ph == 9 ? 1 : 0, lds, rcoef == 0.0f); break;
    case 7: case 10: phase_dn_out(p, ph == 10 ? 1 : 0, rcoef == 0.0f); break;
    case 11: { EpiBf16Y e; e.O = Y; run_gemm(lds, (const bf16_t*)(ws + OFF_QKV) + 1024, 3072, (const bf16_t*)(ws + OFF_WDNOUT), T, DM, DM, e); } break;
    case 12: phase_rowwise(p.out, p.out, Y, ng + 3 * DM, rcoef, ng + 4 * DM, H); break;
    case 19: { EpiSgIn e; e.U = (bf16_t*)(ws + OFF_U); e.V = (bf16_t*)(ws + OFF_V); e.bias = p.sg_b_in;
        run_gemm(lds, H, DM, (const bf16_t*)(ws + OFF_WSGIN), T, 4096, DM, e); } break;
    case 20: phase_sg_stats(p); break;
    case 21: phase_sg_mix(p, lds, rcoef == 0.0f); break;
    case 22: { EpiBf16Y e; e.O = Y; run_gemm(lds, (const bf16_t*)(ws + OFF_U), 2048, (const bf16_t*)(ws + OFF_WSGOUT), T, DM, 2048, e); } break;
    case 23: phase_rowwise(p.out, p.out, Y, ng + (6 + 3) * DM, rcoef, ng + (6 + 4) * DM, H); break;
    default: break;
    }
}

constexpr int LDS_BYTES = 157 * 1024;
static_assert(LDS_WGID_OFF == LDS_BYTES - 8, "logical-id word sits in the top 16 bytes of the LDS array");
static_assert(L_D1END <= LDS_BYTES && pg8::STAGE_BYTES <= LDS_BYTES && L_MX_END + 512 <= LDS_BYTES - 16 && L_MX_ST + 1024 <= L_MX_U, "LDS budget");

__global__ __launch_bounds__(512, 2) void mega(Params p, int ph_lo, int ph_hi) {
    extern __shared__ __attribute__((aligned(16))) unsigned char shm[];
    LAS unsigned char* lds = (LAS unsigned char*)shm;
#ifdef TEST_PH
    run_phase(p, TEST_PH, lds);
#else
#if MK_ONE_LAUNCH
    volatile LAS unsigned* xbst = (volatile LAS unsigned*)(lds + LDS_BYTES - 16);
    if (threadIdx.x == 0) { xbst[0] = 0u; xbst[1] = 0u; }
    __syncthreads();
    const XcdBarrier xb = xcd_barrier_post((unsigned*)(p.ws + OFF_BAR), xbst);
    if (threadIdx.x == 0) { const unsigned rk = xb_add((unsigned*)(p.ws + OFF_BAR) + 3456 + 64 * xb.x, 1u);
        xbst[2] = (xb.x < 8u && rk < 32u && gridDim.x == 256u) ? (xb.x + 8u * rk) : blockIdx.x; }
    __syncthreads();
#else
    if (threadIdx.x == 0) *(volatile LAS unsigned*)(lds + LDS_WGID_OFF) = blockIdx.x;
    __syncthreads();
#endif
    for (int ph = ph_lo; ph < ph_hi; ++ph) {
#if MK_ONE_LAUNCH
        if (ph > ph_lo) { if (ph_hi > 4096) cg::this_grid().sync(); else xcd_barrier(xb); }
#else
        if (ph > ph_lo) cg::this_grid().sync();
#endif
#ifdef PROBE_REP
        if (probe_rep(ph)) {
            Params q0 = p;
            asm volatile("" : "+s"(q0.ws), "+s"(q0.out), "+s"(q0.norm_g), "+s"(q0.x));
            run_phase(q0, ph | 0x100, lds);
            cg::this_grid().sync();
        }
#endif
        Params q = p;
        asm volatile("" : "+s"(q.ws), "+s"(q.out), "+s"(q.norm_g), "+s"(q.x));
        asm volatile("" : "+s"(q.dn_conv_w), "+s"(q.dn_a_log), "+s"(q.dn_dt_bias), "+s"(q.dn_norm_g));
        asm volatile("" : "+s"(q.sg_b_in), "+s"(q.sg_ln_g), "+s"(q.sg_ln_b), "+s"(q.sg_b_s));
        run_phase(q, ph, lds);
    }
#endif
}

extern "C" void kernel_launch(void* const* d_in, const int* in_sizes, int n_in, void* d_out, int out_size, void* d_ws, size_t ws_size, hipStream_t stream) {
    static int grid = 0;
    if (grid == 0) {
        if (n_in != 18 || in_sizes[0] != T * DM || out_size != T * DM || ws_size < WS_END) { fprintf(stderr, "kernel_launch: unexpected shapes (n_in %d, ws %zu, need %zu)\n", n_in, ws_size, (size_t)WS_END); grid = -1; return; }
        if (hipFuncSetAttribute((const void*)mega, hipFuncAttributeMaxDynamicSharedMemorySize, LDS_BYTES) != hipSuccess) { fprintf(stderr, "kernel_launch: hipFuncSetAttribute failed\n"); grid = -1; return; }
        int dev = 0, cus = 0, per_cu = 0;
        hipGetDevice(&dev); hipDeviceGetAttribute(&cus, hipDeviceAttributeMultiprocessorCount, dev);
        hipOccupancyMaxActiveBlocksPerMultiprocessor(&per_cu, (const void*)mega, NTHR, LDS_BYTES);
        if (per_cu < 1) { fprintf(stderr, "kernel_launch: occupancy query says 0 blocks per CU\n"); grid = -1; return; }
        grid = cus;
    }
    if (grid < 0) return;
    Params p{};
    p.x = (const float*)d_in[0]; p.norm_g = (const float*)d_in[1]; p.w_gate = (const float*)d_in[2]; p.w_up = (const float*)d_in[3]; p.w_down = (const float*)d_in[4];
    p.dn_w_in = (const float*)d_in[5]; p.dn_conv_w = (const float*)d_in[6]; p.dn_a_log = (const float*)d_in[7]; p.dn_dt_bias = (const float*)d_in[8]; p.dn_norm_g = (const float*)d_in[9];
    p.dn_w_out = (const float*)d_in[10]; p.sg_w_in = (const float*)d_in[11]; p.sg_b_in = (const float*)d_in[12]; p.sg_ln_g = (const float*)d_in[13]; p.sg_ln_b = (const float*)d_in[14];
    p.sg_w_s = (const float*)d_in[15]; p.sg_b_s = (const float*)d_in[16]; p.sg_w_out = (const float*)d_in[17];
    p.out = (float*)d_out; p.ws = (unsigned char*)d_ws;
#if MK_ONE_LAUNCH
    if (hipMemsetAsync((unsigned char*)d_ws + OFF_BAR, 0, (size_t)XCD_BAR_WORDS * 4, stream) != hipSuccess) { fprintf(stderr, "kernel_launch: hipMemsetAsync of the barrier words failed\n"); return; }
    int lo = 0, hi = NPH;
    void* args[] = {&p, &lo, &hi};
    hipError_t e = hipLaunchCooperativeKernel((const void*)mega, dim3(grid), dim3(NTHR), args, LDS_BYTES, stream);
    if (e != hipSuccess) fprintf(stderr, "cooperative launch failed: %s (grid %d)\n", hipGetErrorString(e), grid);
#else
    for (int ph = 0; ph < NPH; ++ph) {
#ifdef SKIP_DN
        if (ph >= 4 && ph <= 12) continue;
#endif
#ifdef DBG_NOSCAN
        if (ph == 6 || ph == 9) continue;
        if (ph >= 8 && ph <= 10) continue;
#endif
#ifdef SKIP_SG
        if (ph >= 19 && ph <= 23) continue;
#endif
        hipLaunchKernelGGL(mega, dim3(grid), dim3(NTHR), LDS_BYTES, stream, p, ph, ph + 1);
    }
#endif
}
```
